# Optimizing an MI355X kernel written in HIP

```python
import math
import jax, jax.numpy as jnp
from jax import lax
import numpy as np

D_MODEL = 1024
BATCH = 2
SEQ = 16384
DEPTH = 1
DEC_BATCH = 4
DEC_SEQ = 8192
PAST_LEN = 128

EPS = 1e-6
MLA_HEADS = 4
QK_NOPE_DIM = 128
QK_ROPE_DIM = 64
V_HEAD_DIM = 128
Q_LORA_RANK = 384
KV_LORA_RANK = 256
ROPE_THETA = 10000.0
Q_BLOCK = 128
GDN_HEADS = 4
GDN_DK = 128
GDN_DV = 128
CONV_WIDTH = 5
CHUNK = 64
D_FF = 4 * D_MODEL
N_MOD = 6

MLA_WIDTH = MLA_HEADS * V_HEAD_DIM
GDN_WIDTH = GDN_HEADS * GDN_DV
MIX_WIDTH = MLA_WIDTH + GDN_WIDTH
GDN_CONV_CH = 2 * GDN_HEADS * GDN_DK + GDN_HEADS * GDN_DV
IN_SPLITS = (Q_LORA_RANK, KV_LORA_RANK, QK_ROPE_DIM, GDN_CONV_CH, GDN_WIDTH,
             GDN_HEADS, GDN_HEADS, GDN_HEADS, GDN_HEADS)
IN_COLS = sum(IN_SPLITS)

kernel_name = "hymba_mla_gdn_adaln_encoder"


def _split_cols(t, sizes):
    idx = np.cumsum(np.array(sizes))[:-1].tolist()
    return jnp.split(t, idx, axis=-1)


def rms_norm(x, g):
    xf = x.astype(jnp.float32)
    y = xf * lax.rsqrt(jnp.mean(xf * xf, axis=-1, keepdims=True) + EPS)
    return (y * g.astype(jnp.float32)).astype(x.dtype)


def l2_norm(x):
    xf = x.astype(jnp.float32)
    return xf * lax.rsqrt(jnp.sum(xf * xf, axis=-1, keepdims=True) + EPS)


def rotary_tables(S):
    inv = 1.0 / (ROPE_THETA ** (jnp.arange(0, QK_ROPE_DIM, 2, dtype=jnp.float32) / QK_ROPE_DIM))
    ang = jnp.arange(S, dtype=jnp.float32)[:, None] * inv[None, :]
    return jnp.cos(ang), jnp.sin(ang)


def apply_rope(x, cos, sin):
    xf = x.astype(jnp.float32)
    x1, x2 = jnp.split(xf, 2, axis=-1)
    return jnp.concatenate([x1 * cos - x2 * sin, x2 * cos + x1 * sin], axis=-1).astype(x.dtype)


def mla_mixer(cq, ckv, kr, g_q, w_uq, g_kv, w_ukv):
    B, S, _ = cq.shape
    cos, sin = rotary_tables(S)
    scale = (QK_NOPE_DIM + QK_ROPE_DIM) ** -0.5
    q = (rms_norm(cq, g_q) @ w_uq).reshape(B, S, MLA_HEADS, QK_NOPE_DIM + QK_ROPE_DIM)
    q_nope = q[..., :QK_NOPE_DIM] * scale
    q_rope = apply_rope(q[..., QK_NOPE_DIM:], cos[:, None, :], sin[:, None, :]) * scale
    kv = (rms_norm(ckv, g_kv) @ w_ukv).reshape(B, S, MLA_HEADS, QK_NOPE_DIM + V_HEAD_DIM)
    k_nope, v = kv[..., :QK_NOPE_DIM], kv[..., QK_NOPE_DIM:]
    k_rope = apply_rope(kr, cos, sin)
    nb = S // Q_BLOCK

    def blocks(t):
        return jnp.moveaxis(t.reshape(B, nb, Q_BLOCK, *t.shape[2:]), 1, 0)

    def attend(qb):
        qn, qr = qb
        s = (jnp.einsum('bqhd,bkhd->bhqk', qn, k_nope)
             + jnp.einsum('bqhr,bkr->bhqk', qr, k_rope)).astype(jnp.float32)
        p = jax.nn.softmax(s, axis=-1).astype(v.dtype)
        return jnp.einsum('bhqk,bkhd->bqhd', p, v)

    o = lax.map(attend, (blocks(q_nope), blocks(q_rope)))
    return jnp.moveaxis(o, 0, 1).reshape(B, S, MLA_WIDTH)


def gated_delta_chunked(q, k, v, g, beta):
    B, S, H, Dk = q.shape
    Dv = v.shape[-1]
    C = CHUNK
    N = S // C
    f32 = jnp.float32
    q = q.astype(f32) * (Dk ** -0.5)
    k = k.astype(f32)
    v = v.astype(f32)

    def to_chunks(t):
        return t.reshape(B, N, C, H, t.shape[-1]).transpose(0, 3, 1, 2, 4)

    q, k, v = to_chunks(q), to_chunks(k), to_chunks(v)
    g = g.astype(f32).reshape(B, N, C, H).transpose(0, 3, 1, 2)
    beta = beta.astype(f32).reshape(B, N, C, H).transpose(0, 3, 1, 2)
    g = jnp.cumsum(g, axis=-1)
    k_beta = k * beta[..., None]
    v_beta = v * beta[..., None]
    lower = jnp.tril(jnp.ones((C, C), dtype=bool))
    strict = jnp.tril(jnp.ones((C, C), dtype=bool), -1)
    diff = g[..., :, None] - g[..., None, :]
    decay = jnp.where(lower, jnp.exp(jnp.where(lower, diff, 0.0)), 0.0)
    a_mat = jnp.where(strict, jnp.einsum('bhncd,bhnmd->bhncm', k_beta, k) * decay, 0.0)
    t_mat = a_mat + jnp.eye(C, dtype=f32)
    u = lax.linalg.triangular_solve(t_mat, v_beta, left_side=True, lower=True, unit_diagonal=True)
    w = lax.linalg.triangular_solve(t_mat, k_beta * jnp.exp(g)[..., None], left_side=True,
                                    lower=True, unit_diagonal=True)
    attn = jnp.where(lower, jnp.einsum('bhncd,bhnmd->bhncm', q, k) * decay, 0.0)
    g_last = g[..., -1]
    k_tail = k * jnp.exp(g_last[..., None] - g)[..., None]
    q_dec = q * jnp.exp(g)[..., None]

    def step(state, inp):
        q_i, kt_i, u_i, w_i, at_i, gl_i = inp
        v_new = u_i - jnp.einsum('bhcd,bhde->bhce', w_i, state)
        o_i = jnp.einsum('bhcd,bhde->bhce', q_i, state) + jnp.einsum('bhcm,bhme->bhce', at_i, v_new)
        state = state * jnp.exp(gl_i)[..., None, None] + jnp.einsum('bhcd,bhce->bhde', kt_i, v_new)
        return state, o_i

    xs = tuple(jnp.moveaxis(t, 2, 0) for t in (q_dec, k_tail, u, w, attn, g_last))
    s0 = jnp.zeros((B, H, Dk, Dv), f32)
    _, o = lax.scan(step, s0, xs)
    return o.transpose(1, 0, 3, 2, 4).reshape(B, S, H, Dv)


def gdn_mixer(qkv, z, a_f, a_b, b_f, b_b, conv_w, a_log_f, a_log_b, dt_f, dt_b, g_gdn):
    B, S, _ = qkv.shape
    pad = CONV_WIDTH // 2
    qkv = lax.conv_general_dilated(qkv, conv_w[:, None, :].astype(qkv.dtype), window_strides=(1,),
                                   padding=[(pad, pad)], dimension_numbers=('NWC', 'WIO', 'NWC'),
                                   feature_group_count=GDN_CONV_CH)
    qkv = jax.nn.silu(qkv)
    q, k, v = _split_cols(qkv, (GDN_HEADS * GDN_DK, GDN_HEADS * GDN_DK, GDN_WIDTH))
    q = l2_norm(q.reshape(B, S, GDN_HEADS, GDN_DK))
    k = l2_norm(k.reshape(B, S, GDN_HEADS, GDN_DK))
    v = v.reshape(B, S, GDN_HEADS, GDN_DV)

    def log_decay(a, a_log, dt):
        return -jnp.exp(a_log.astype(jnp.float32)) * jax.nn.softplus(a.astype(jnp.float32) + dt.astype(jnp.float32))

    g_fwd, g_bwd = log_decay(a_f, a_log_f, dt_f), log_decay(a_b, a_log_b, dt_b)
    beta_fwd, beta_bwd = jax.nn.sigmoid(b_f.astype(jnp.float32)), jax.nn.sigmoid(b_b.astype(jnp.float32))
    flip = lambda t: jnp.flip(t, axis=1)
    o_fwd = gated_delta_chunked(q, k, v, g_fwd, beta_fwd)
    o_bwd = flip(gated_delta_chunked(flip(q), flip(k), flip(v), flip(g_bwd), flip(beta_bwd)))
    o = rms_norm(o_fwd + o_bwd, g_gdn) * jax.nn.silu(z.reshape(B, S, GDN_HEADS, GDN_DV).astype(jnp.float32))
    return o.reshape(B, S, GDN_WIDTH).astype(z.dtype)


def encoder_layer(x, mod, g_mix, w_in, g_q, w_uq, g_kv, w_ukv, conv_w, a_log_f, a_log_b, dt_f, dt_b,
                  g_gdn, w_out, g_mlp, w_mlp_in, w_mlp_out):
    shift_a, scale_a, gate_a, shift_m, scale_m, gate_m = jnp.split(mod[:, None, :], N_MOD, axis=-1)
    h = rms_norm(x, g_mix) * (1.0 + scale_a) + shift_a
    proj = h @ w_in
    cq, ckv, kr, qkv, z, a_f, a_b, b_f, b_b = _split_cols(proj, IN_SPLITS)
    o_mla = mla_mixer(cq, ckv, kr, g_q, w_uq, g_kv, w_ukv)
    o_gdn = gdn_mixer(qkv, z, a_f, a_b, b_f, b_b, conv_w, a_log_f, a_log_b, dt_f, dt_b, g_gdn)
    mixed = jnp.concatenate([o_mla, o_gdn], axis=-1) @ w_out
    x = x + gate_a * mixed
    h = rms_norm(x, g_mlp) * (1.0 + scale_m) + shift_m
    x = x + gate_m * (jnp.square(jax.nn.relu(h @ w_mlp_in)) @ w_mlp_out)
    return x


def run_trunk(x, c, w_ada, b_ada, g_mix, w_in, g_q, w_uq, g_kv, w_ukv, conv_w, a_log_f, a_log_b,
              dt_f, dt_b, g_gdn, w_out, g_mlp, w_mlp_in, w_mlp_out, w_ada_f, b_ada_f, g_final):
    sc = jax.nn.silu(c)
    for l in range(DEPTH):
        mod = sc @ w_ada[l] + b_ada[l]
        x = encoder_layer(x, mod, g_mix[l], w_in[l], g_q[l], w_uq[l], g_kv[l], w_ukv[l], conv_w[l],
                          a_log_f[l], a_log_b[l], dt_f[l], dt_b[l], g_gdn[l], w_out[l], g_mlp[l],
                          w_mlp_in[l], w_mlp_out[l])
    shift_f, scale_f = jnp.split((sc @ w_ada_f + b_ada_f)[:, None, :], 2, axis=-1)
    return rms_norm(x, g_final) * (1.0 + scale_f) + shift_f


def setup_inputs(seed: int = 0) -> dict:
    key = jax.random.key(seed)
    ks = jax.random.split(key, 26)
    f32 = jnp.float32
    L, D = DEPTH, D_MODEL

    def nrm(k, shape, fan_in):
        return jax.random.normal(k, shape, f32) * (fan_in ** -0.5)

    def gain(k, shape):
        return 1.0 + 0.02 * jax.random.normal(k, shape, f32)

    def dt_bias(k):
        dt = jnp.exp(jax.random.uniform(k, (L, GDN_HEADS), f32) * (math.log(0.1) - math.log(0.001)) + math.log(0.001))
        return dt + jnp.log(-jnp.expm1(-dt))

    return {
        "x_prompt": jax.random.normal(ks[0], (BATCH, SEQ, D), f32),
        "x_sample": jax.random.normal(ks[1], (DEC_BATCH, DEC_SEQ, D), f32),
        "c_prompt": jax.random.normal(ks[2], (BATCH, D), f32),
        "c_sample": jax.random.normal(ks[3], (DEC_BATCH, D), f32),
        "w_ada": nrm(ks[4], (L, D, N_MOD * D), D),
        "b_ada": 0.02 * jax.random.normal(ks[5], (L, N_MOD * D), f32),
        "g_mix": gain(ks[6], (L, D)),
        "w_in": nrm(ks[7], (L, D, IN_COLS), D),
        "g_q": gain(ks[8], (L, Q_LORA_RANK)),
        "w_uq": nrm(ks[9], (L, Q_LORA_RANK, MLA_HEADS * (QK_NOPE_DIM + QK_ROPE_DIM)), Q_LORA_RANK),
        "g_kv": gain(ks[10], (L, KV_LORA_RANK)),
        "w_ukv": nrm(ks[11], (L, KV_LORA_RANK, MLA_HEADS * (QK_NOPE_DIM + V_HEAD_DIM)), KV_LORA_RANK),
        "conv_w": nrm(ks[12], (L, CONV_WIDTH, GDN_CONV_CH), CONV_WIDTH),
        "a_log_f": jnp.log(jax.random.uniform(ks[13], (L, GDN_HEADS), f32, 1.0, 16.0)),
        "a_log_b": jnp.log(jax.random.uniform(ks[14], (L, GDN_HEADS), f32, 1.0, 16.0)),
        "dt_f": dt_bias(ks[15]),
        "dt_b": dt_bias(ks[16]),
        "g_gdn": gain(ks[17], (L, GDN_DV)),
        "w_out": nrm(ks[18], (L, MIX_WIDTH, D), MIX_WIDTH),
        "g_mlp": gain(ks[19], (L, D)),
        "w_mlp_in": nrm(ks[20], (L, D, D_FF), D),
        "w_mlp_out": nrm(ks[21], (L, D_FF, D), D_FF),
        "w_ada_f": nrm(ks[22], (D, 2 * D), D),
        "b_ada_f": 0.02 * jax.random.normal(ks[23], (2 * D,), f32),
        "g_final": gain(ks[24], (D,)),
    }


def reference(x_prompt, x_sample, c_prompt, c_sample, w_ada, b_ada, g_mix, w_in, g_q, w_uq, g_kv, w_ukv,
              conv_w, a_log_f, a_log_b, dt_f, dt_b, g_gdn, w_out, g_mlp, w_mlp_in, w_mlp_out,
              w_ada_f, b_ada_f, g_final):
    y_prompt = run_trunk(x_prompt, c_prompt, w_ada, b_ada, g_mix, w_in, g_q, w_uq, g_kv, w_ukv, conv_w,
                         a_log_f, a_log_b, dt_f, dt_b, g_gdn, w_out, g_mlp, w_mlp_in, w_mlp_out,
                         w_ada_f, b_ada_f, g_final)
    y_sample = run_trunk(x_sample, c_sample, w_ada, b_ada, g_mix, w_in, g_q, w_uq, g_kv, w_ukv, conv_w,
                         a_log_f, a_log_b, dt_f, dt_b, g_gdn, w_out, g_mlp, w_mlp_in, w_mlp_out,
                         w_ada_f, b_ada_f, g_final)
    return (y_prompt, y_sample)
```

```cpp
#include <hip/hip_runtime.h>
#include <hip/hip_cooperative_groups.h>
#include <cstdio>
#include <cstdint>
#include <cmath>
namespace cg = cooperative_groups;

#ifndef N_LAUNCH_MODE
#define N_LAUNCH_MODE 1
#endif
#ifndef ATT_REP
#define ATT_REP 1
#endif
#ifndef SCAN_REP
#define SCAN_REP 1
#endif
#ifndef GDN_DBG
#define GDN_DBG 0
#endif
#ifndef ENABLE_MLA
#define ENABLE_MLA 1
#endif
#ifndef ENABLE_GDN
#define ENABLE_GDN 1
#endif

#define LAS __attribute__((address_space(3)))
typedef unsigned short bf16_t;
typedef short bf16x8 __attribute__((ext_vector_type(8)));
typedef short bf16x4 __attribute__((ext_vector_type(4)));
typedef float f32x4 __attribute__((ext_vector_type(4)));
typedef float f32x2 __attribute__((ext_vector_type(2)));
typedef unsigned u32x4 __attribute__((ext_vector_type(4)));
typedef unsigned u32x2 __attribute__((ext_vector_type(2)));

constexpr int M_TOK = 65536, DM = 1024, NSEQ = 6, FF = 4096;
constexpr int N_IN = 2816;
constexpr float EPS = 1e-6f;
constexpr float QSCALE = 0.07216878364870322f * 1.4426950408889634f;
constexpr float DKS = 0.08838834764831845f;

__device__ __forceinline__ int seq_of_row(int r) { return r < 32768 ? (r >> 14) : 2 + ((r - 32768) >> 13); }
__device__ __forceinline__ int seq_start(int s) { return s < 2 ? s * 16384 : 32768 + (s - 2) * 8192; }
__device__ __forceinline__ int seq_len(int s) { return s < 2 ? 16384 : 8192; }

constexpr size_t MiB = 1u << 20;
constexpr size_t WS_WIN = 0, WS_WUQ = 6 * MiB, WS_WUKV = 7 * MiB, WS_WOUT = 8 * MiB, WS_W1 = 10 * MiB, WS_W2 = 18 * MiB;
constexpr size_t WS_MOD = 26 * MiB, WS_MODF = 26 * MiB + 256 * 1024, WS_RSQ = 26 * MiB + 512 * 1024, WS_RSKV = 26 * MiB + 768 * 1024;
constexpr size_t WS_CTL = 26 * MiB + 384 * 1024, CTL_BYTES = 65536;
constexpr size_t WS_GATES = 27 * MiB;
constexpr size_t WS_R1 = 32 * MiB;
constexpr size_t WS_TINV = WS_R1, WS_ATT = WS_R1 + 64 * MiB;
constexpr size_t WS_R2 = 160 * MiB;
constexpr size_t WS_Z = 352 * MiB;
constexpr size_t WS_A = 416 * MiB;
constexpr size_t WS_END = 512 * MiB;
constexpr size_t DO_GQ = 0, DO_GK = 64 * MiB, DO_GV = 128 * MiB, DO_KT = 192 * MiB;
constexpr size_t DO_Q = 0, DO_KVP = 192 * MiB, WS_KVS = 288 * MiB;

typedef __bf16 bf16x2_t __attribute__((ext_vector_type(2)));
__device__ __forceinline__ unsigned cvt_pk(float lo, float hi) { f32x2 v = {lo, hi}; bf16x2_t b = __builtin_convertvector(v, bf16x2_t); return __builtin_bit_cast(unsigned, b); }
__device__ __forceinline__ float bf_lo(unsigned w) { return __uint_as_float(w << 16); }
__device__ __forceinline__ float bf_hi(unsigned w) { return __uint_as_float(w & 0xffff0000u); }
__device__ __forceinline__ float bf1(bf16_t h) { return __uint_as_float(((unsigned)h) << 16); }
__device__ __forceinline__ bf16_t f2bf(float f) { return (bf16_t)(cvt_pk(f, 0.f) & 0xffffu); }
__device__ __forceinline__ float wave_sum(float v) {
#pragma unroll
    for (int o = 1; o < 64; o <<= 1) v += __shfl_xor(v, o);
    return v;
}
__device__ __forceinline__ float siluf(float x) { return x / (1.f + __expf(-x)); }
__device__ __forceinline__ float row16_sum(float v) {
    v += __int_as_float(__builtin_amdgcn_update_dpp(0, __float_as_int(v), 0x128, 0xF, 0xF, false));
    v += __int_as_float(__builtin_amdgcn_update_dpp(0, __float_as_int(v), 0x124, 0xF, 0xF, false));
    v += __int_as_float(__builtin_amdgcn_update_dpp(0, __float_as_int(v), 0x122, 0xF, 0xF, false));
    v += __int_as_float(__builtin_amdgcn_update_dpp(0, __float_as_int(v), 0x121, 0xF, 0xF, false));
    return v;
}

__constant__ double c_invrev[32] = {0.15915494309189535, 0.11934937021124886, 0.08949940160889101, 0.06711508300522726, 0.050329212104487035, 0.03774158471741977, 0.0283021958306234, 0.02122365276477766, 0.015915494309189534, 0.011934937021124886, 0.008949940160889102, 0.006711508300522725, 0.005032921210448704, 0.003774158471741977, 0.00283021958306234, 0.0021223652764777662, 0.0015915494309189536, 0.0011934937021124885, 0.0008949940160889102, 0.0006711508300522726, 0.0005032921210448703, 0.00037741584717419774, 0.00028302195830623395, 0.0002122365276477766, 0.00015915494309189535, 0.00011934937021124886, 8.949940160889102e-05, 6.711508300522725e-05, 5.0329212104487035e-05, 3.774158471741978e-05, 2.8302195830623396e-05, 2.122365276477766e-05};
__device__ __forceinline__ void gate_vals(const bf16_t* bufA, int row, int d, int h, const float* alog_f, const float* alog_b, const float* dt_f, const float* dt_b, float& g, float& beta) {
    const float va = bf1(bufA[(size_t)row * 768 + 704 + d * 4 + h]), vb = bf1(bufA[(size_t)row * 768 + 712 + d * 4 + h]);
    const float alog = d ? alog_b[h] : alog_f[h], dt = d ? dt_b[h] : dt_f[h];
    const float z = va + dt; const float sp = fmaxf(z, 0.f) + log1pf(__expf(-fabsf(z)));
    g = -__expf(alog) * sp; beta = 1.f / (1.f + __expf(-vb));
}

namespace pg8 {
#define PG8_LAS __attribute__((address_space(3)))
constexpr int BM = 256, BK = 64, HALF = 128, HTB = HALF * BK * 2  , STAGE_BYTES = 8 * HTB, NXCD = 8, WGM = 8;

__host__ __device__ __forceinline__ int lds_byte(int r, int c) { const int st = (r >> 4) * 2 + (c >> 5), rr = r & 15, cc = c & 31, ob = rr * 64 + cc * 2; return st * 1024 + (ob ^ (((ob >> 9) & 1) << 5)); }
__host__ __device__ __forceinline__ void stage_rc(int b, int& R, int& C) { const int st = b / 1024, sb = b % 1024, swz = sb ^ (((sb >> 9) & 1) << 5); R = (st >> 1) * 16 + swz / 64; C = (st & 1) * 32 + (swz % 64) / 2; }
__host__ __device__ __forceinline__ int perm32(int rho) { const int n = rho >> 4, i = rho & 15; return 8 * (i >> 2) + 4 * n + (i & 3); }

struct Unit { int pm, pn; };
struct Gemm { const bf16_t* A; const bf16_t* Bt; int M, N, K, lda; };

struct StaticOrder {
    int nM, nN, nwg, G, c;
    __host__ __device__ void init(int M, int N, int G_, int c_) { nM = M / BM; nN = N / BM; nwg = nM * nN; G = G_; c = c_; }
    __host__ __device__ bool next(int i, Unit& u) const {
        const long L = (long)i * G + c; if (L >= nwg) return false;
        int wgid = (int)L; { const int q = nwg / NXCD, r = nwg % NXCD, xcd = wgid % NXCD, off = wgid / NXCD; wgid = (xcd < r ? xcd * (q + 1) : r * (q + 1) + (xcd - r) * q) + off; }
        const int nig = WGM * nN, gid = wgid / nig, fm = gid * WGM, gsz = (nM - fm) < WGM ? (nM - fm) : WGM;
        u.pm = fm + ((wgid % nig) % gsz); u.pn = (wgid % nig) / gsz; return true;
    }
    __device__ __forceinline__ void a_ready(const Unit&) const {}
    __device__ __forceinline__ void done(const Unit&) const {}
};


__device__ __forceinline__ u32x4 pack8(f32x4 v0, f32x4 v1) { u32x4 w; w.x = cvt_pk(v0[0], v0[1]); w.y = cvt_pk(v0[2], v0[3]); w.z = cvt_pk(v1[0], v1[1]); w.w = cvt_pk(v1[2], v1[3]); return w; }

struct EpiProj {
    static constexpr bool PERM = true, AFTER_DRAIN = false;
    bf16_t *bA, *bQ, *bZ;
    __device__ __forceinline__ void operator()(const f32x4 (&acc)[2][2][4][2], const Unit& u, int wr, int wc, int fr, int fq) const {
        const int row0 = u.pm * BM + wr * 64 + fr, cw = wc * 32 + 8 * fq;
        bf16_t* b0; bf16_t* b1; int ld;
        if (u.pn < 3) { ld = 768; b0 = bA + u.pn * 256 + cw; b1 = b0 + HALF; }
        else if (u.pn < 9) { ld = 128; b0 = bQ + (size_t)(2 * (u.pn - 3)) * M_TOK * 128 + cw; b1 = b0 + (size_t)M_TOK * 128; }
        else { ld = 512; b0 = bZ + (u.pn - 9) * 256 + cw; b1 = b0 + HALF; }
#pragma unroll
        for (int ai = 0; ai < 2; ++ai)
#pragma unroll
            for (int m = 0; m < 4; ++m) { const size_t ro = (size_t)(row0 + ai * HALF + m * 16) * ld;
                *(u32x4*)(b0 + ro) = pack8(acc[ai][0][m][0], acc[ai][0][m][1]); *(u32x4*)(b1 + ro) = pack8(acc[ai][1][m][0], acc[ai][1][m][1]); }
    }
};
template <int ACT> struct EpiBf16 {
    static constexpr bool PERM = true, AFTER_DRAIN = false;
    bf16_t* O; int ld; const float* rowscale; float mul;
    __device__ __forceinline__ void operator()(const f32x4 (&acc)[2][2][4][2], const Unit& u, int wr, int wc, int fr, int fq) const {
        const int row0 = u.pm * BM + wr * 64 + fr, col0 = u.pn * BM + wc * 32 + 8 * fq;
#pragma unroll
        for (int ai = 0; ai < 2; ++ai)
#pragma unroll
            for (int m = 0; m < 4; ++m) { const int row = row0 + ai * HALF + m * 16; bf16_t* rowp = O + (size_t)row * ld + col0; const float rs = rowscale ? rowscale[row] * mul : 1.f;
#pragma unroll
                for (int bj = 0; bj < 2; ++bj) { f32x4 v0 = acc[ai][bj][m][0], v1 = acc[ai][bj][m][1];
                    if (ACT == 1) {
#pragma unroll
                        for (int e = 0; e < 4; ++e) { const float a = fmaxf(v0[e], 0.f), b = fmaxf(v1[e], 0.f); v0[e] = a * a; v1[e] = b * b; } }
                    else { v0 = v0 * rs; v1 = v1 * rs; }
                    *(u32x4*)(rowp + bj * HALF) = pack8(v0, v1); } }
    }
};
template <int MODE> struct EpiResB {
    static constexpr bool PERM = true, AFTER_DRAIN = false;
    const float* xp; const float* xs; bf16_t* X1; const float* gate; int row_off;
    __device__ __forceinline__ void operator()(const f32x4 (&acc)[2][2][4][2], const Unit& u, int wr, int wc, int fr, int fq) const {
        const int rowt = row_off + u.pm * BM; const int col0 = u.pn * BM + wc * 32 + 8 * fq;
        const float* gp = gate + (size_t)seq_of_row(rowt) * 6144 + col0;
        f32x4 gv[2][2];
#pragma unroll
        for (int bj = 0; bj < 2; ++bj)
#pragma unroll
            for (int n = 0; n < 2; ++n) gv[bj][n] = *(const f32x4*)(gp + bj * HALF + n * 4);
#pragma unroll
        for (int ai = 0; ai < 2; ++ai) {
            f32x4 bv[4][2][2];
#pragma unroll
            for (int m = 0; m < 4; ++m) { const int row = rowt + wr * 64 + fr + ai * HALF + m * 16;
                if (MODE == 0) { const float* xr = row < 32768 ? xp + (size_t)row * DM : xs + (size_t)(row - 32768) * DM;
#pragma unroll
                    for (int bj = 0; bj < 2; ++bj)
#pragma unroll
                        for (int n = 0; n < 2; ++n) bv[m][bj][n] = *(const f32x4*)(xr + col0 + bj * HALF + n * 4); }
                else {
#pragma unroll
                    for (int bj = 0; bj < 2; ++bj) { const u32x4 w = *(const u32x4*)(X1 + (size_t)row * DM + col0 + bj * HALF);
                        bv[m][bj][0] = (f32x4){bf_lo(w.x), bf_hi(w.x), bf_lo(w.y), bf_hi(w.y)}; bv[m][bj][1] = (f32x4){bf_lo(w.z), bf_hi(w.z), bf_lo(w.w), bf_hi(w.w)}; } } }
            asm volatile("" ::: "memory");
#pragma unroll
            for (int m = 0; m < 4; ++m) { const int row = rowt + wr * 64 + fr + ai * HALF + m * 16;
#pragma unroll
                for (int bj = 0; bj < 2; ++bj) *(u32x4*)(X1 + (size_t)row * DM + col0 + bj * HALF) = pack8(bv[m][bj][0] + gv[bj][0] * acc[ai][bj][m][0], bv[m][bj][1] + gv[bj][1] * acc[ai][bj][m][1]); }
            asm volatile("" ::: "memory");
        }
    }
};
template <int MODE> struct EpiRes {
    static constexpr bool PERM = false, AFTER_DRAIN = false;
    const float* xp; const float* xs; float* out; const float* gate; int row_off;
    __device__ __forceinline__ void operator()(const f32x4 (&acc)[2][2][4][2], const Unit& u, int wr, int wc, int fr, int fq) const {
        const int rowt = row_off + u.pm * BM; const int col0 = u.pn * BM + wc * 32 + 4 * fq;
        const float* gp = gate + (size_t)seq_of_row(rowt) * 6144 + col0;
        f32x4 gv[2][2];
#pragma unroll
        for (int bj = 0; bj < 2; ++bj)
#pragma unroll
            for (int n = 0; n < 2; ++n) gv[bj][n] = *(const f32x4*)(gp + bj * HALF + n * 16);
#pragma unroll
        for (int ai = 0; ai < 2; ++ai) {
            f32x4 bv[4][2][2];
#pragma unroll
            for (int m = 0; m < 4; ++m) { const int row = rowt + wr * 64 + fr + ai * HALF + m * 16;
                const float* xr = MODE == 0 ? (row < 32768 ? xp + (size_t)row * DM : xs + (size_t)(row - 32768) * DM) : out + (size_t)row * DM;
#pragma unroll
                for (int bj = 0; bj < 2; ++bj)
#pragma unroll
                    for (int n = 0; n < 2; ++n) bv[m][bj][n] = *(const f32x4*)(xr + col0 + bj * HALF + n * 16); }
            asm volatile("" ::: "memory");
#pragma unroll
            for (int m = 0; m < 4; ++m) { const int row = rowt + wr * 64 + fr + ai * HALF + m * 16; float* orow = out + (size_t)row * DM;
#pragma unroll
                for (int bj = 0; bj < 2; ++bj)
#pragma unroll
                    for (int n = 0; n < 2; ++n) *(f32x4*)(orow + col0 + bj * HALF + n * 16) = bv[m][bj][n] + gv[bj][n] * acc[ai][bj][m][n]; }
            asm volatile("" ::: "memory");
        }
    }
};
template <class Epi, class Sched, bool ALIGN_EPI = false>
__device__ __forceinline__ void gemm_phase(PG8_LAS unsigned char* lds, const Gemm g, const Sched& S, const Epi& E) {
    int tid_ = threadIdx.x; asm volatile("" : "+v"(tid_));
    const int tid = tid_, wid = __builtin_amdgcn_readfirstlane(tid >> 6), lane = tid & 63, wr = wid >> 2, wc = wid & 3, fr = lane & 15, fq = lane >> 4;
    const int K = g.K, nt = K / BK;
    unsigned voffA[2], voffB[2];
#pragma unroll
    for (int i = 0; i < 2; ++i) { int R, C; stage_rc(tid * 16 + i * 8192, R, C); const int Rb = Epi::PERM ? ((R & ~31) + perm32(R & 31)) : R;
        voffA[i] = (unsigned)(R * g.lda + C) * 2u; voffB[i] = (unsigned)(Rb * K + C) * 2u; }
    const size_t kstep = (size_t)(BK * 2);
    const size_t hstepA = (size_t)HALF * g.lda * 2, hstepB = (size_t)HALF * K * 2;
    const size_t tstepA = 2 * hstepA, tstepB = 2 * hstepB;
    const unsigned ldsw = (unsigned)wid * 1024u;
    const int aoff = lds_byte(wr * 64 + fr, fq * 8), boff = lds_byte(wc * 32 + fr, fq * 8);
#define PG8_SA(b, h) (((b) * 2 + (h)) * HTB)
#define PG8_SB(b, h) ((4 + (b) * 2 + (h)) * HTB)
#define PG8_STAGE(bufoff, gbase, voff) do { _Pragma("unroll") for (int _i = 0; _i < 2; ++_i) \
        __builtin_amdgcn_global_load_lds((const unsigned*)((const char*)(gbase) + (voff)[_i]), (PG8_LAS unsigned*)(lds + (bufoff) + ldsw + _i * 8192), 16, 0, 0); } while (0)
#define PG8_LDA(dst, b, h) do { _Pragma("unroll") for (int m = 0; m < 4; ++m) _Pragma("unroll") for (int k = 0; k < 2; ++k) dst[m][k] = *(const PG8_LAS bf16x8*)(lds + PG8_SA(b, h) + aoff + m * 2048 + k * 1024); } while (0)
#define PG8_LDB(dst, b, h) do { _Pragma("unroll") for (int n = 0; n < 2; ++n) _Pragma("unroll") for (int k = 0; k < 2; ++k) dst[n][k] = *(const PG8_LAS bf16x8*)(lds + PG8_SB(b, h) + boff + n * 2048 + k * 1024); } while (0)
#define PG8_MMA(ai, bj, At, Bt) do { __builtin_amdgcn_s_setprio(1); _Pragma("unroll") for (int m = 0; m < 4; ++m) _Pragma("unroll") for (int n = 0; n < 2; ++n) _Pragma("unroll") for (int k = 0; k < 2; ++k) \
        acc[ai][bj][m][n] = __builtin_amdgcn_mfma_f32_16x16x32_bf16(Bt[n][k], At[m][k], acc[ai][bj][m][n], 0, 0, 0); __builtin_amdgcn_s_setprio(0); } while (0)
#define PG8_WAIT_V(n) asm volatile("s_waitcnt vmcnt(" #n ")" ::: "memory")
#define PG8_WAIT_L(n) asm volatile("s_waitcnt lgkmcnt(" #n ")" ::: "memory")
#define PG8_BAR __builtin_amdgcn_s_barrier()
#define PG8_SCHED __builtin_amdgcn_sched_barrier(0)
    Unit cur, nxt; int ui = 0;
    if (!S.next(0, cur)) return;
    f32x4 acc[2][2][4][2];
#pragma unroll
    for (int a = 0; a < 2; ++a)
#pragma unroll
        for (int b = 0; b < 2; ++b)
#pragma unroll
            for (int m = 0; m < 4; ++m)
#pragma unroll
                for (int n = 0; n < 2; ++n) acc[a][b][m][n] = (f32x4){0.f, 0.f, 0.f, 0.f};
    bf16x8 At[4][2], B0[2][2], B1[2][2];
    const char* cA = (const char*)g.A + (size_t)cur.pm * tstepA; const char* cB = (const char*)g.Bt + (size_t)cur.pn * tstepB;
    S.a_ready(cur);
    PG8_STAGE(PG8_SB(0, 0), cB, voffB); PG8_STAGE(PG8_SB(0, 1), cB + hstepB, voffB); PG8_STAGE(PG8_SA(0, 0), cA, voffA); PG8_STAGE(PG8_SA(0, 1), cA + hstepA, voffA);
    if (wr == 1) PG8_BAR;
    PG8_WAIT_V(2); PG8_BAR;
    PG8_STAGE(PG8_SB(1, 0), cB + kstep, voffB); PG8_STAGE(PG8_SA(1, 0), cA + kstep, voffA); PG8_STAGE(PG8_SB(1, 1), cB + hstepB + kstep, voffB);
    PG8_WAIT_V(6); PG8_BAR;
    for (;;) {
        const bool has_next = S.next(ui + 1, nxt);
        const char* nA = has_next ? (const char*)g.A + (size_t)nxt.pm * tstepA : cA; const char* nB = has_next ? (const char*)g.Bt + (size_t)nxt.pn * tstepB : cB;
        for (int t = 0; t < nt; t += 2) {
            const bool last = (t == nt - 2);
            const char* a1 = cA + (size_t)(t + 1) * kstep;
            const char* a2 = last ? nA : cA + (size_t)(t + 2) * kstep; const char* b2 = last ? nB : cB + (size_t)(t + 2) * kstep;
            const char* a3 = a2 + kstep; const char* b3 = b2 + kstep;
            if (last && has_next) S.a_ready(nxt);
            PG8_LDB(B0, 0, 0); PG8_LDB(B1, 0, 1); PG8_SCHED; PG8_LDA(At, 0, 0); PG8_STAGE(PG8_SA(1, 1), a1 + hstepA, voffA);
            PG8_WAIT_V(8); PG8_WAIT_L(0); PG8_BAR; PG8_MMA(0, 0, At, B0); PG8_MMA(0, 1, At, B1); PG8_BAR; PG8_SCHED;
            PG8_LDA(At, 0, 1); PG8_STAGE(PG8_SB(0, 0), b2, voffB); PG8_STAGE(PG8_SB(0, 1), b2 + hstepB, voffB); PG8_STAGE(PG8_SA(0, 0), a2, voffA);
            PG8_WAIT_V(8); PG8_WAIT_L(0); PG8_BAR; PG8_MMA(1, 0, At, B0); PG8_MMA(1, 1, At, B1); PG8_BAR; PG8_SCHED;
            PG8_LDB(B0, 1, 0); PG8_LDB(B1, 1, 1); PG8_SCHED; PG8_LDA(At, 1, 0); PG8_STAGE(PG8_SA(0, 1), a2 + hstepA, voffA);
            PG8_WAIT_V(8); PG8_WAIT_L(0); PG8_BAR; PG8_MMA(0, 0, At, B0); PG8_MMA(0, 1, At, B1); PG8_BAR; PG8_SCHED;
            PG8_LDA(At, 1, 1); PG8_STAGE(PG8_SB(1, 0), b3, voffB); PG8_STAGE(PG8_SB(1, 1), b3 + hstepB, voffB); PG8_STAGE(PG8_SA(1, 0), a3, voffA);
            PG8_WAIT_V(8); PG8_WAIT_L(0); PG8_BAR; PG8_MMA(1, 0, At, B0); PG8_MMA(1, 1, At, B1); PG8_BAR; PG8_SCHED;
        }
        if constexpr (ALIGN_EPI) { if (wr == 0) PG8_BAR; }
        if constexpr (!Epi::AFTER_DRAIN) { E(acc, cur, wr, wc, fr, fq); S.done(cur); }
        if (!has_next) break;
#pragma unroll
        for (int a = 0; a < 2; ++a)
#pragma unroll
            for (int b = 0; b < 2; ++b)
#pragma unroll
                for (int m = 0; m < 4; ++m)
#pragma unroll
                    for (int n = 0; n < 2; ++n) acc[a][b][m][n] = (f32x4){0.f, 0.f, 0.f, 0.f};
        cur = nxt; cA = nA; cB = nB; ++ui;
        if constexpr (ALIGN_EPI) { if (wr == 1) PG8_BAR; }
    }
    PG8_WAIT_V(0);
    if constexpr (!ALIGN_EPI) { if (wr == 0) PG8_BAR; }
    PG8_BAR;
    if constexpr (Epi::AFTER_DRAIN) { E.fused(acc, cur, wr, wc, fr, fq, lds, wid, lane); S.done(cur); }
#undef PG8_SA
#undef PG8_SB
#undef PG8_STAGE
#undef PG8_LDA
#undef PG8_LDB
#undef PG8_MMA
#undef PG8_WAIT_V
#undef PG8_WAIT_L
#undef PG8_BAR
#undef PG8_SCHED
}
}


__device__ __forceinline__ int map_col(int kind, int n) {
    if (kind == 1) { if (n < 704) return n; if (n < 720) return 2752 + (n - 704); if (n < 768) return -1; return 704 + (n - 768); }
    if (kind == 2) { const int hd = n / 192, j = n % 192; if (j < 128) return n; const int i2 = j - 128; return hd * 192 + 128 + (i2 >> 1) + 32 * (i2 & 1); }
    return n;
}
__device__ __forceinline__ void transpose_item(const float* W, int K, int Nsrc, int Ndst, bf16_t* WT, const float* kscale, int kind, LAS float* scr, int item, int lane) {
    const int nblk = Ndst / 32, kb = item / nblk, nb = item % nblk, k0 = 64 * kb, n0 = 32 * nb;
    const int sc_ = map_col(kind, n0 + (lane & 31));
#pragma unroll 8
    for (int i = 0; i < 32; ++i) { const int kk = 2 * i + (lane >> 5); float v = 0.f;
        if (sc_ >= 0) { v = W[(size_t)(k0 + kk) * Nsrc + sc_]; if (kscale) v *= kscale[k0 + kk]; }
        scr[kk * 33 + (lane & 31)] = v; }
    asm volatile("s_waitcnt lgkmcnt(0)" ::: "memory");
    const int c = lane & 7;
#pragma unroll
    for (int j = 0; j < 4; ++j) { const int n = (lane >> 3) + 8 * j; const LAS float* s = scr + (8 * c) * 33 + n;
        u32x4 o; o.x = cvt_pk(s[0 * 33], s[1 * 33]); o.y = cvt_pk(s[2 * 33], s[3 * 33]); o.z = cvt_pk(s[4 * 33], s[5 * 33]); o.w = cvt_pk(s[6 * 33], s[7 * 33]);
        *(u32x4*)(WT + (size_t)(n0 + n) * K + k0 + 8 * c) = o; }
    asm volatile("s_waitcnt lgkmcnt(0)" ::: "memory");
}

template <bool OUT_BF16> __device__ __forceinline__ void norm_mod_row2(const float* xrow0, const float* xrow1, const float* g, const float* scale0, const float* shift0, const float* scale1, const float* shift1,
                                                                       void* orow0, void* orow1, int lane) {
    const f32x4* xr0 = (const f32x4*)xrow0 + lane; const f32x4* xr1 = (const f32x4*)xrow1 + lane;
    f32x4 v0[4], v1[4]; float s0 = 0.f, s1 = 0.f;
#pragma unroll
    for (int j = 0; j < 4; ++j) { v0[j] = xr0[64 * j]; v1[j] = xr1[64 * j]; }
#pragma unroll
    for (int j = 0; j < 4; ++j) { s0 += (v0[j].x * v0[j].x + v0[j].y * v0[j].y) + (v0[j].z * v0[j].z + v0[j].w * v0[j].w); s1 += (v1[j].x * v1[j].x + v1[j].y * v1[j].y) + (v1[j].z * v1[j].z + v1[j].w * v1[j].w); }
    const float rstd0 = rsqrtf(wave_sum(s0) * (1.f / DM) + EPS), rstd1 = rsqrtf(wave_sum(s1) * (1.f / DM) + EPS);
#pragma unroll
    for (int j = 0; j < 4; ++j) { const int c = 4 * (64 * j + lane);
        const f32x4 gg = *(const f32x4*)(g + c);
        const f32x4 y0 = (v0[j] * rstd0) * gg * (*(const f32x4*)(scale0 + c) + 1.f) + *(const f32x4*)(shift0 + c);
        const f32x4 y1 = (v1[j] * rstd1) * gg * (*(const f32x4*)(scale1 + c) + 1.f) + *(const f32x4*)(shift1 + c);
        if (OUT_BF16) { u32x2 w; w.x = cvt_pk(y0.x, y0.y); w.y = cvt_pk(y0.z, y0.w); *((u32x2*)orow0 + 64 * j + lane) = w; w.x = cvt_pk(y1.x, y1.y); w.y = cvt_pk(y1.z, y1.w); *((u32x2*)orow1 + 64 * j + lane) = w; }
        else { *((f32x4*)orow0 + 64 * j + lane) = y0; *((f32x4*)orow1 + 64 * j + lane) = y1; } }
}

template <bool OUT_BF16> __device__ __forceinline__ void norm_rows_b(int m0, int stride, const bf16_t* xin, const float* g, const float* modb, int mstride, int soff, int hoff, bf16_t* ob, float* of, int lane) {
    int mr[2]; u32x4 v[2][2]; float rstd[2];
#pragma unroll
    for (int k = 0; k < 2; ++k) { const int m = m0 + k * stride; mr[k] = m < M_TOK ? m : m0;
#pragma unroll
        for (int j = 0; j < 2; ++j) v[k][j] = *(const u32x4*)(xin + (size_t)mr[k] * DM + 512 * j + lane * 8); }
#pragma unroll
    for (int k = 0; k < 2; ++k) { float s = 0.f;
#pragma unroll
        for (int j = 0; j < 2; ++j) { const u32x4 w = v[k][j]; const float x0 = bf_lo(w.x), x1 = bf_hi(w.x), x2 = bf_lo(w.y), x3 = bf_hi(w.y), x4 = bf_lo(w.z), x5 = bf_hi(w.z), x6 = bf_lo(w.w), x7 = bf_hi(w.w);
            s += (x0 * x0 + x1 * x1) + (x2 * x2 + x3 * x3) + (x4 * x4 + x5 * x5) + (x6 * x6 + x7 * x7); }
        rstd[k] = rsqrtf(wave_sum(s) * (1.f / DM) + EPS); }
#pragma unroll
    for (int j = 0; j < 2; ++j) { const int c = 512 * j + lane * 8; const f32x4 g0 = *(const f32x4*)(g + c), g1 = *(const f32x4*)(g + c + 4);
#pragma unroll
        for (int k = 0; k < 2; ++k) { const float* md = modb + (size_t)seq_of_row(mr[k]) * mstride; const u32x4 w = v[k][j];
            const f32x4 xa = {bf_lo(w.x), bf_hi(w.x), bf_lo(w.y), bf_hi(w.y)}, xb = {bf_lo(w.z), bf_hi(w.z), bf_lo(w.w), bf_hi(w.w)};
            const f32x4 ya = (xa * rstd[k]) * g0 * (*(const f32x4*)(md + soff + c) + 1.f) + *(const f32x4*)(md + hoff + c);
            const f32x4 yb = (xb * rstd[k]) * g1 * (*(const f32x4*)(md + soff + c + 4) + 1.f) + *(const f32x4*)(md + hoff + c + 4);
            if (OUT_BF16) *(u32x4*)(ob + (size_t)mr[k] * DM + c) = (u32x4){cvt_pk(ya.x, ya.y), cvt_pk(ya.z, ya.w), cvt_pk(yb.x, yb.y), cvt_pk(yb.z, yb.w)};
            else { *(f32x4*)(of + (size_t)mr[k] * DM + c) = ya; *(f32x4*)(of + (size_t)mr[k] * DM + c + 4) = yb; } } }
}

namespace att {
using f32x16 = __attribute__((ext_vector_type(16))) float;
using s16x4 = __attribute__((ext_vector_type(4))) short;
constexpr int NW = 8, QBLK = 32, KVBLK = 64, DQK = 192, DV = 128;
constexpr int LDQ = 768, LDKV = 1024, LDR = 768, LDO = 1024;
constexpr float THRL = 11.5f;
constexpr int NSLOT = 3;
constexpr size_t SHM_V = KVBLK * DV * 2, SHM_K = KVBLK * DQK * 2, SHM_QS = NSLOT * SHM_V + NSLOT * SHM_K + NW * 64 * 4, SHM_ATTN = SHM_QS + NW * 4096;
#define KSWZ(row, colB) ((row) * 384 + ((colB) ^ ((((row) >> 1) & 7) << 4)))
#define SBAR() __builtin_amdgcn_sched_barrier(0)
__device__ __forceinline__ int crow(int r, int hi) { return (r & 3) + 8 * (r >> 2) + 4 * hi; }
__device__ __forceinline__ void partialSM(f32x16& p0, f32x16& p1, float& m_reg, float& mn, float& alpha) {
    float pmax = p0[0];
#pragma unroll
    for (int r = 1; r < 16; ++r) pmax = fmaxf(pmax, p0[r]);
#pragma unroll
    for (int r = 0; r < 16; ++r) pmax = fmaxf(pmax, p1[r]);
    { auto rr = __builtin_amdgcn_permlane32_swap(__float_as_uint(pmax), __float_as_uint(pmax), false, false);
      pmax = fmaxf(__uint_as_float(rr[0]), __uint_as_float(rr[1])); }
    if (__builtin_expect(__all(pmax - m_reg <= THRL), 1)) { mn = m_reg; alpha = 1.f; }
    else { mn = fmaxf(m_reg, pmax); alpha = __builtin_amdgcn_exp2f(m_reg - mn); m_reg = mn; }
#pragma unroll
    for (int r = 0; r < 16; ++r) p0[r] = p0[r] - mn;
#pragma unroll
    for (int r = 0; r < 16; ++r) p1[r] = p1[r] - mn;
#pragma unroll
    for (int r = 0; r < 16; ++r) p0[r] = __builtin_amdgcn_exp2f(p0[r]);
}
__device__ __forceinline__ void finishSM(f32x16& p0, f32x16& p1, float alpha, float& l_reg, bf16x8& pa0, bf16x8& pa1, bf16x8& pa2, bf16x8& pa3) {
#pragma unroll
    for (int r = 0; r < 16; ++r) p1[r] = __builtin_amdgcn_exp2f(p1[r]);
    float ps = 0;
#pragma unroll
    for (int r = 0; r < 16; ++r) ps += p0[r];
#pragma unroll
    for (int r = 0; r < 16; ++r) ps += p1[r];
    { auto rr = __builtin_amdgcn_permlane32_swap(__float_as_uint(ps), __float_as_uint(ps), false, false);
      ps = __uint_as_float(rr[0]) + __uint_as_float(rr[1]); }
    l_reg = l_reg * alpha + ps;
#define PK4(P, BASE, OUT) do { unsigned a0 = cvt_pk(P[BASE + 0], P[BASE + 1]), a1 = cvt_pk(P[BASE + 2], P[BASE + 3]);   \
    unsigned b0 = cvt_pk(P[BASE + 4], P[BASE + 5]), b1 = cvt_pk(P[BASE + 6], P[BASE + 7]);                              \
    auto r0 = __builtin_amdgcn_permlane32_swap(a0, b0, false, false); auto r1 = __builtin_amdgcn_permlane32_swap(a1, b1, false, false); \
    u32x4 w = {r0[0], r1[0], r0[1], r1[1]}; OUT = *reinterpret_cast<bf16x8*>(&w); } while (0)
    PK4(p0, 0, pa0); PK4(p0, 8, pa1); PK4(p1, 0, pa2); PK4(p1, 8, pa3);
#undef PK4
}
__device__ __forceinline__ void qkt(f32x16& p0, f32x16& p1, const char* Ks, const bf16x8* qr, const char* Qs, int r32, int hi) {
    p0 = f32x16{}; p1 = f32x16{};
#pragma unroll
    for (int d0 = 0; d0 < 12; ++d0) { const int cb = (d0 * 16 + hi * 8) * 2;
        const bf16x8 qf = qr[d0];
        const bf16x8 b0 = *reinterpret_cast<const bf16x8*>(Ks + KSWZ(r32, cb));
        const bf16x8 b1 = *reinterpret_cast<const bf16x8*>(Ks + KSWZ(32 + r32, cb));
        p0 = __builtin_amdgcn_mfma_f32_32x32x16_bf16(b0, qf, p0, 0, 0, 0);
        p1 = __builtin_amdgcn_mfma_f32_32x32x16_bf16(b1, qf, p1, 0, 0, 0); }
}
__device__ __forceinline__ int v_st(int k, int c) { const int kk = (k & ~0xC) | ((k & 4) << 1) | ((k & 8) >> 1); return ((kk >> 3) * 4 + (c >> 5)) * 512 + ((kk & 7) * 32 + (c & 31)) * 2; }
__device__ __forceinline__ int v_rd_base(int lane) { return ((lane & 3) << 3) | (((lane >> 2) & 3) << 6) | (((lane >> 4) & 1) << 5) | (((lane >> 5) & 1) << 8); }
constexpr int v_rd_off(int d0, int ks, int half) { return d0 * 512 + ks * 4096 + half * 2048; }
template <int OFF> __device__ __forceinline__ s16x4 tr_read(int vb) {
    s16x4 r; asm volatile("ds_read_b64_tr_b16 %0, %1 offset:%2" : "=&v"(r) : "v"(vb), "i"(OFF) : "memory"); return r;
}
template <int D0> __device__ __forceinline__ void pv_one(f32x16& od, int vb, bf16x8 pa0, bf16x8 pa1, bf16x8 pa2, bf16x8 pa3) {
    const s16x4 l0 = tr_read<v_rd_off(D0, 0, 0)>(vb), h0 = tr_read<v_rd_off(D0, 0, 1)>(vb), l1 = tr_read<v_rd_off(D0, 1, 0)>(vb), h1 = tr_read<v_rd_off(D0, 1, 1)>(vb);
    const s16x4 l2 = tr_read<v_rd_off(D0, 2, 0)>(vb), h2 = tr_read<v_rd_off(D0, 2, 1)>(vb), l3 = tr_read<v_rd_off(D0, 3, 0)>(vb), h3 = tr_read<v_rd_off(D0, 3, 1)>(vb);
    asm volatile("s_waitcnt lgkmcnt(0)" ::: "memory"); SBAR();
#define PK(L, H) (bf16x8){L[0], L[1], L[2], L[3], H[0], H[1], H[2], H[3]}
    od = __builtin_amdgcn_mfma_f32_32x32x16_bf16(pa0, PK(l0, h0), od, 0, 0, 0);
    od = __builtin_amdgcn_mfma_f32_32x32x16_bf16(pa1, PK(l1, h1), od, 0, 0, 0);
    od = __builtin_amdgcn_mfma_f32_32x32x16_bf16(pa2, PK(l2, h2), od, 0, 0, 0);
    od = __builtin_amdgcn_mfma_f32_32x32x16_bf16(pa3, PK(l3, h3), od, 0, 0, 0);
#undef PK
}
__device__ __forceinline__ void pv_d0(f32x16* o, int vb, bf16x8 pa0, bf16x8 pa1, bf16x8 pa2, bf16x8 pa3) {
    pv_one<0>(o[0], vb, pa0, pa1, pa2, pa3); pv_one<1>(o[1], vb, pa0, pa1, pa2, pa3); pv_one<2>(o[2], vb, pa0, pa1, pa2, pa3); pv_one<3>(o[3], vb, pa0, pa1, pa2, pa3);
}
__device__ __forceinline__ void attn_unit(const bf16_t* __restrict__ Qb, const bf16_t* __restrict__ Kn, const bf16_t* __restrict__ Vh, const bf16_t* __restrict__ Kr,
                                          bf16_t* __restrict__ Ob, int seq, int pos0, char* lds) {
    int tid_ = threadIdx.x; asm volatile("" : "+v"(tid_));
    const int tid = tid_, wid = tid >> 6, lane = tid & 63, r32 = lane & 31, hi = lane >> 5;
    char* V_lds = lds; char* K_lds = lds + NSLOT * SHM_V; char* Qs = lds + SHM_QS + wid * 4096 + lane * 16;
    float* ws = (float*)(lds + NSLOT * SHM_V + NSLOT * SHM_K) + wid * 64; float* li_l = ws; float* al_l = ws + 32;
    float m_reg = -1e30f, l_reg = 0; f32x16 o[4] = {}; bf16x8 qr[12];
    const bf16_t* Qw = Qb + (long)(wid * QBLK + r32) * LDQ + hi * 8;
#pragma unroll
    for (int d0 = 0; d0 < 8; ++d0) qr[d0] = *reinterpret_cast<const bf16x8*>(Qw + d0 * 16);
#pragma unroll
    for (int d0 = 8; d0 < 12; ++d0) {
        const u32x4 qv = *reinterpret_cast<const u32x4*>(Qw + d0 * 16); const double pos = (double)(pos0 + wid * QBLK + r32); unsigned w[4] = {qv.x, qv.y, qv.z, qv.w};
#pragma unroll
        for (int t = 0; t < 4; ++t) { const double rev = pos * c_invrev[(d0 - 8) * 8 + hi * 4 + t]; const float fr_ = (float)(rev - rint(rev));
            const float sn = __builtin_amdgcn_sinf(fr_), cs = __builtin_amdgcn_cosf(fr_); const float x1 = bf_lo(w[t]), x2 = bf_hi(w[t]);
            w[t] = cvt_pk(x1 * cs - x2 * sn, x2 * cs + x1 * sn); }
        const u32x4 wq = {w[0], w[1], w[2], w[3]}; qr[d0] = __builtin_bit_cast(bf16x8, wq); }
    const int vb0 = (int)(uintptr_t)V_lds + v_rd_base(lane);
    const bf16_t* dk_[3]; int dks_[3]; const bf16_t* dv_[2];
#pragma unroll
    for (int i = 0; i < 3; ++i) { const int p = (wid * 3 + i) * 64 + lane, row = p / 24, cq = p % 24, c = (cq & ~7) | ((cq & 7) ^ ((row >> 1) & 7));
        dk_[i] = c < 16 ? Kn + (long)row * LDKV + c * 8 : Kr + (long)row * LDR + (c - 16) * 8; dks_[i] = c < 16 ? LDKV : LDR; }
#pragma unroll
    for (int i = 0; i < 2; ++i) { const int p = (wid * 2 + i) * 64 + lane, sub = p >> 5, within = p & 31, kk = (sub >> 2) * 8 + (within >> 2), c = (sub & 3) * 32 + (within & 3) * 8;
        const int k = (kk & ~0xC) | ((kk & 4) << 1) | ((kk & 8) >> 1); dv_[i] = Vh + (long)k * LDKV + c; }
    const unsigned ldsK0 = (unsigned)(uintptr_t)K_lds + (unsigned)__builtin_amdgcn_readfirstlane(wid) * 3072u, ldsV0 = (unsigned)(uintptr_t)V_lds + (unsigned)__builtin_amdgcn_readfirstlane(wid) * 2048u;
#define DMA_TILE(k0, slot) do { \
    _Pragma("unroll") for (int i_ = 0; i_ < 3; ++i_) __builtin_amdgcn_global_load_lds((const unsigned*)(dk_[i_] + (long)(k0) * dks_[i_]), (LAS unsigned*)(ldsK0 + (unsigned)(slot) * (unsigned)SHM_K + i_ * 1024u), 16, 0, 0); \
    _Pragma("unroll") for (int i_ = 0; i_ < 2; ++i_) __builtin_amdgcn_global_load_lds((const unsigned*)(dv_[i_] + (long)(k0) * LDKV), (LAS unsigned*)(ldsV0 + (unsigned)(slot) * (unsigned)SHM_V + i_ * 1024u), 16, 0, 0); } while (0)
#define SWAIT() asm volatile("s_waitcnt vmcnt(0)" ::: "memory")
#define RESC(a) do { if (__any((a) < 1.f)) { if (hi == 0) al_l[r32] = (a); asm volatile("s_waitcnt lgkmcnt(0)" ::: "memory"); \
    _Pragma("unroll") for (int d = 0; d < 4; ++d) _Pragma("unroll") for (int r = 0; r < 16; ++r) o[d][r] *= al_l[crow(r, hi)]; } } while (0)
    f32x16 pA0, pA1, pB0, pB1; float mnA, mnB, alA, alB; bf16x8 pa0, pa1, pa2, pa3; const int NT = seq / KVBLK;
    int s_prev = 0, s_cur = 1, s_next = 2;
    DMA_TILE(0, 0); DMA_TILE(KVBLK, 1); SWAIT(); __syncthreads();
    qkt(pA0, pA1, K_lds, qr, Qs, r32, hi); partialSM(pA0, pA1, m_reg, mnA, alA);
#define ROT3() do { const int t_ = s_prev; s_prev = s_cur; s_cur = s_next; s_next = t_; } while (0)
#define ASTEP(j, N0, N1, MN_N, AL_N, O0, O1, AL_O) do { \
        SBAR(); DMA_TILE(((j) + 1) * KVBLK, s_next); SBAR();        \
        qkt(N0, N1, K_lds + s_cur * SHM_K, qr, Qs, r32, hi); \
        finishSM(O0, O1, AL_O, l_reg, pa0, pa1, pa2, pa3); SBAR(); \
        pv_d0(o, vb0 + s_prev * (int)SHM_V, pa0, pa1, pa2, pa3); partialSM(N0, N1, m_reg, MN_N, AL_N); \
        SWAIT(); \
        RESC(AL_N); __syncthreads(); ROT3(); } while (0)
    for (int j = 1; j + 1 < NT; j += 2) {
        ASTEP(j, pB0, pB1, mnB, alB, pA0, pA1, alA);
        ASTEP(j + 1, pA0, pA1, mnA, alA, pB0, pB1, alB);
    }
    SBAR(); qkt(pB0, pB1, K_lds + s_cur * SHM_K, qr, Qs, r32, hi);
    finishSM(pA0, pA1, alA, l_reg, pa0, pa1, pa2, pa3); SBAR();
    pv_d0(o, vb0 + s_prev * (int)SHM_V, pa0, pa1, pa2, pa3); partialSM(pB0, pB1, m_reg, mnB, alB);
    RESC(alB);
    finishSM(pB0, pB1, alB, l_reg, pa0, pa1, pa2, pa3); SBAR();
    pv_d0(o, vb0 + s_cur * (int)SHM_V, pa0, pa1, pa2, pa3);
#undef ASTEP
#undef ROT3
    if (hi == 0) li_l[r32] = l_reg; asm volatile("s_waitcnt lgkmcnt(0)" ::: "memory");
    float rli[16];
#pragma unroll
    for (int r = 0; r < 16; ++r) rli[r] = __builtin_amdgcn_rcpf(li_l[crow(r, hi)]);
    bf16_t* Ow = Ob + (long)(wid * QBLK) * LDO;
#pragma unroll
    for (int r = 0; r < 16; ++r) { const int orow = crow(r, hi);
#pragma unroll
        for (int d0 = 0; d0 < 4; ++d0) Ow[(long)orow * LDO + d0 * 32 + r32] = f2bf(o[d0][r] * rli[r]); }
    __syncthreads();
#undef DMA_TILE
#undef SWAIT
#undef RESC
}
#undef KSWZ
#undef SBAR
}

__device__ __forceinline__ f32x4 mfma16(bf16x8 a, bf16x8 b, f32x4 c) { return __builtin_amdgcn_mfma_f32_16x16x32_bf16(a, b, c, 0, 0, 0); }
constexpr int PL_QN = 0, PL_KN = 17408, PL_KK = 34816, PL_QK = 51456, PL_A0 = 68096, PL_GC = 100864, PL_BT = 101376;
__device__ __forceinline__ void gdn_prep_item(int cgi, int h, LAS unsigned char* lds, const bf16_t* bufQKV, const float* convw, const bf16_t* bufA, const float* alf, const float* alb, const float* dtf, const float* dtb,
                                              bf16_t* GQ, bf16_t* GK, bf16_t* GV, bf16_t* KT, bf16_t* TINV, bf16_t* ATT, float* gcum) {
    int tid_ = threadIdx.x; asm volatile("" : "+v"(tid_));
    const int tid = tid_, wave = __builtin_amdgcn_readfirstlane(tid >> 6), lane = tid & 63;
    const int r0 = cgi * 64, sq = seq_of_row(r0), slo = seq_start(sq), shi = slo + seq_len(sq);
    if (tid < 384) {
        const int p = tid % 48, rg = tid / 48, sec = p >> 4, w = p & 15, col = sec * 512 + h * 128 + w * 8;
        f32x4 cw[5][2];
#pragma unroll
        for (int tap = 0; tap < 5; ++tap) { cw[tap][0] = *(const f32x4*)(convw + tap * 1536 + col); cw[tap][1] = *(const f32x4*)(convw + tap * 1536 + col + 4); }
        u32x4 xin[12];
#pragma unroll
        for (int q = 0; q < 12; ++q) { const int rr = r0 + rg * 8 + q - 2; xin[q] = (u32x4){0u, 0u, 0u, 0u};
            if (rr >= slo && rr < shi) xin[q] = *(const u32x4*)(bufQKV + ((size_t)(sec * 4 + h) * M_TOK + rr) * 128 + w * 8); }
        const int gld = sec < 2 ? 128 : 32;
        bf16_t* gbase = sec < 2 ? (sec == 0 ? GQ : GK) + ((size_t)h * M_TOK + r0 + rg * 8) * 128 + w * 8 : GV + ((size_t)(h * 4 + (w >> 2)) * M_TOK + r0 + rg * 8) * 32 + (w & 3) * 8;
#pragma unroll
        for (int rr = 0; rr < 8; ++rr) {
            float a[8] = {0.f, 0.f, 0.f, 0.f, 0.f, 0.f, 0.f, 0.f};
#pragma unroll
            for (int tap = 0; tap < 5; ++tap) { const u32x4 xv = xin[rr + tap]; const f32x4 c0 = cw[tap][0], c1 = cw[tap][1];
                a[0] += bf_lo(xv.x) * c0[0]; a[1] += bf_hi(xv.x) * c0[1]; a[2] += bf_lo(xv.y) * c0[2]; a[3] += bf_hi(xv.y) * c0[3];
                a[4] += bf_lo(xv.z) * c1[0]; a[5] += bf_hi(xv.z) * c1[1]; a[6] += bf_lo(xv.w) * c1[2]; a[7] += bf_hi(xv.w) * c1[3]; }
            float ss = 0.f;
#pragma unroll
            for (int e = 0; e < 8; ++e) { a[e] = siluf(a[e]); ss += a[e] * a[e]; }
            ss = row16_sum(ss);
            const float sc = sec < 2 ? rsqrtf(ss + EPS) : 1.f;
            u32x4 w8; w8.x = cvt_pk(a[0] * sc, a[1] * sc); w8.y = cvt_pk(a[2] * sc, a[3] * sc); w8.z = cvt_pk(a[4] * sc, a[5] * sc); w8.w = cvt_pk(a[6] * sc, a[7] * sc);
            *(u32x4*)(gbase + (size_t)rr * gld) = w8;
            if (sec < 2) *(LAS u32x4*)(lds + (sec ? PL_KN : PL_QN) + ((rg * 8 + rr) * 136 + w * 8) * 2) = w8;
        }
    }
    __syncthreads();
    { const int l15 = lane & 15, l4 = lane >> 4;
#pragma unroll
      for (int tt = 0; tt < 4; ++tt) { const int t = wave * 4 + tt, mat = t >> 4, ti = (t >> 2) & 3, tj = t & 3; f32x4 acc = {0.f, 0.f, 0.f, 0.f};
#pragma unroll
          for (int ks = 0; ks < 4; ++ks) { const bf16x8 av = *(const LAS bf16x8*)(lds + (mat ? PL_QN : PL_KN) + ((16 * ti + l15) * 136 + 32 * ks + 8 * l4) * 2);
              const bf16x8 bv = *(const LAS bf16x8*)(lds + PL_KN + ((16 * tj + l15) * 136 + 32 * ks + 8 * l4) * 2); acc = mfma16(av, bv, acc); }
          LAS float* dst = (LAS float*)(lds + (mat ? PL_QK : PL_KK));
#pragma unroll
          for (int r = 0; r < 4; ++r) dst[(16 * ti + 4 * l4 + r) * 65 + 16 * tj + l15] = acc[r]; } }
    LAS float* GC = (LAS float*)(lds + PL_GC); LAS float* BT = (LAS float*)(lds + PL_BT);
    if (wave < 2) { const int d = wave, row = r0 + (d ? 63 - lane : lane);
        float gc, b; gate_vals(bufA, row, d, h, alf, alb, dtf, dtb, gc, b);
#pragma unroll
        for (int off = 1; off < 64; off <<= 1) { const float t = __shfl_up(gc, off); if (lane >= off) gc += t; }
        GC[d * 64 + lane] = gc; BT[d * 64 + lane] = b; gcum[(size_t)row * 16 + d * 4 + h] = gc; }
    __syncthreads();
    { const LAS float* KK = (const LAS float*)(lds + PL_KK); const LAS float* QK = (const LAS float*)(lds + PL_QK); LAS float* Ad = (LAS float*)(lds + PL_A0);
#pragma unroll 2
      for (int it = 0; it < 8; ++it) { const int e2 = tid + 512 * it, d = e2 >> 11, i = (e2 >> 5) & 63, j0 = (e2 & 31) * 2, ri = d ? 63 - i : i;
          const float gi = GC[d * 64 + i], bi = BT[d * 64 + i]; float at[2];
#pragma unroll
          for (int q = 0; q < 2; ++q) { const int j = j0 + q, rj = d ? 63 - j : j; const float dec = __expf(fminf(gi - GC[d * 64 + j], 0.f));
              Ad[d * 4096 + i * 64 + (j & 3) * 16 + (j >> 2)] = (j < i) ? KK[ri * 65 + rj] * bi * dec : 0.f;
              at[q] = (j <= i) ? QK[ri * 65 + rj] * dec * DKS : 0.f; }
          *(unsigned*)(ATT + ((size_t)((cgi * 4 + h) * 2 + d) * 64 + i) * 64 + j0) = cvt_pk(at[0], at[1]); } }
    __syncthreads();
    { const int idx = wave * 16 + (lane >> 2), d = idx >> 6, c = idx & 63, ph = lane & 3;
      const LAS float* A = (const LAS float*)(lds + PL_A0) + d * 4096 + ph * 16; float Xq[16];
#pragma unroll
      for (int q = 0; q < 16; ++q) Xq[q] = 0.f;
      bf16_t* T = TINV + (size_t)((cgi * 4 + h) * 2 + d) * 4096 + c;
#pragma unroll
      for (int i = 0; i < 64; ++i) { float part = 0.f;
#pragma unroll
          for (int jj = 0; jj < (i + 3) / 4; ++jj) part += A[i * 64 + jj] * Xq[jj];
          part += __int_as_float(__builtin_amdgcn_update_dpp(0, __float_as_int(part), 0xB1, 0xF, 0xF, false));
          part += __int_as_float(__builtin_amdgcn_update_dpp(0, __float_as_int(part), 0x4E, 0xF, 0xF, false));
          const float xi = ((i == c) ? 1.f : 0.f) - part;
          if (ph == (i & 3)) { Xq[i >> 2] = xi; T[i * 64] = f2bf(xi); } } }
    __syncthreads();
}

constexpr int SB_SZ = 58368, SB_QC = 17408, SB_TI = 34816, SB_AT = 44032, SB_VC = 53248;
constexpr int SL_ST = 116736, SL_RH = 125440, SL_VN = 130048, SL_VS = 134656, SL_SC = 139264, SL_SC_SZ = 1280;
#define SCAN_BAR() do { asm volatile("s_waitcnt lgkmcnt(0)" ::: "memory"); __builtin_amdgcn_s_barrier(); asm volatile("" ::: "memory"); } while (0)
template <int DVS>
__device__ __forceinline__ void gdn_scan_chain(int shd, int dvs, LAS unsigned char* lds, const float* gates, const bf16_t* GQ, const bf16_t* GK, const bf16_t* GV,
                                               const bf16_t* TINV, const bf16_t* ATT, bf16_t* OD) {
    constexpr int VP = DVS / 8 + 1, VLD = DVS + 8;
    constexpr int NPIECE = 3328 + 64 * VP, NDMA = (NPIECE + 63) / 64;
    constexpr int NDT = DVS / 16;
    int tid_ = threadIdx.x; asm volatile("" : "+v"(tid_));
    const int tid = tid_, wave = __builtin_amdgcn_readfirstlane(tid >> 6), lane = tid & 63, l15 = lane & 15, l4 = lane >> 4;
    const int sq = shd >> 3, h = (shd >> 1) & 3, d = shd & 1;
    const int N = seq_len(sq) / 64, c0g = seq_start(sq) / 64;
    const bool act = wave < 4 * NDT; const int tm = act ? wave >> 2 : 0, tn = wave & 3;
    const int sdv = NDT == 2 ? wave >> 2 : 0, sdk0 = NDT == 2 ? (wave & 3) * 2 : wave;
    const int v_slab = DVS == 32 ? dvs : dvs >> 1, v_col = DVS == 32 ? 0 : (dvs & 1) * 16;
    const bf16_t* src0[8]; int sstep[8];
#pragma unroll
    for (int t = 0; t < 8; ++t) { const int q = wave + 8 * t, P = q * 64 + lane; const bf16_t* b = GK; int st = 0;
        if (P < 2176) { const int pp = P < 1088 ? P : P - 1088, ip = pp / 17, pc = pp % 17, rm = d ? 63 - ip : ip; b = (P < 1088 ? GK : GQ) + ((size_t)h * M_TOK + rm) * 128 + (pc < 16 ? pc : 0) * 8; st = 64 * 128; }
        else if (P < 3328) { const int pp = P < 2752 ? P - 2176 : P - 2752, ip = pp / 9, pc = pp % 9; b = (P < 2752 ? TINV : ATT) + ((size_t)(h * 2 + d) * 64 + ip) * 64 + (pc < 8 ? pc : 0) * 8; st = 32768; }
        else if (P < NPIECE) { const int pp = P - 3328, ip = pp / VP, pc = pp % VP, rm = d ? 63 - ip : ip; b = GV + ((size_t)(h * 4 + v_slab) * M_TOK + rm) * 32 + v_col + (pc < VP - 1 ? pc : 0) * 8; st = 64 * 32; }
        src0[t] = b; sstep[t] = st; }
    const unsigned ldsb = (unsigned)(uintptr_t)lds;
    float pg = 0.f, pb = 0.f;
#define SC_DMA(n, nb) do { const int cgi_ = c0g + (d ? N - 1 - (n) : (n)); \
    if (wave == 0) { const size_t go_ = (size_t)(cgi_ * 64 + (d ? 63 - lane : lane)) * 16 + d * 4 + h; pg = gates[go_]; pb = gates[go_ + 8]; } \
    _Pragma("unroll") for (int t_ = 0; t_ < 8; ++t_) if (wave + 8 * t_ < NDMA) \
        __builtin_amdgcn_global_load_lds((const unsigned*)(src0[t_] + (size_t)cgi_ * sstep[t_]), (LAS unsigned*)(ldsb + (unsigned)(nb) * SB_SZ + (unsigned)(wave + 8 * t_) * 1024u), 16, 0, 0); } while (0)
#define SC_SCAL(nb) do { if (wave == 0) { const float gc_ = pg;            \
        const float gl_ = __int_as_float(__builtin_amdgcn_readlane(__float_as_int(gc_), 63)); LAS float* S_ = (LAS float*)(lds + SL_SC + (nb) * SL_SC_SZ); const float eg_ = __expf(gc_); \
        S_[lane] = pb * eg_; S_[64 + lane] = eg_ * DKS; S_[128 + lane] = __expf(gl_ - gc_); S_[192 + lane] = pb; if (lane == 0) S_[256] = __expf(gl_); } } while (0)
    for (int i = tid; i < 32 * 136 / 2; i += 512) ((LAS unsigned*)(lds + SL_ST))[i] = 0u;
    f32x4 Sx[NDT];
#pragma unroll
    for (int t = 0; t < NDT; ++t) Sx[t] = (f32x4){0.f, 0.f, 0.f, 0.f};
    SC_DMA(0, 0); SC_SCAL(0);
    asm volatile("s_waitcnt vmcnt(0)" ::: "memory"); SCAN_BAR();
    const int cp = 16 * tn + l15, dv0 = 16 * tm + 4 * l4;
#pragma unroll 1
    for (int n = 0; n < N; ++n) {
        const int cur = n & 1; const bool more = n + 1 < N;
        const LAS unsigned char* B = lds + cur * SB_SZ;
        if (more) SC_DMA(n + 1, cur ^ 1);
        const LAS float* SC = (const LAS float*)(lds + SL_SC + cur * SL_SC_SZ);
        f32x4 qs = {0.f, 0.f, 0.f, 0.f};
        if (act) {
            f32x4 aT = {0.f, 0.f, 0.f, 0.f}, aQ = {0.f, 0.f, 0.f, 0.f};
#pragma unroll
            for (int ks = 0; ks < 4; ++ks) { const bf16x8 a = *(const LAS bf16x8*)(lds + SL_ST + ((16 * tm + l15) * 136 + 32 * ks + 8 * l4) * 2);
                const bf16x8 bk = *(const LAS bf16x8*)(B + ((16 * tn + l15) * 136 + 32 * ks + 8 * l4) * 2);
                const bf16x8 bq = *(const LAS bf16x8*)(B + SB_QC + ((16 * tn + l15) * 136 + 32 * ks + 8 * l4) * 2);
                aT = mfma16(a, bk, aT); aQ = mfma16(a, bq, aQ); }
            const u32x2 vv = *(const LAS u32x2*)(B + SB_VC + (cp * VLD + dv0) * 2); const float bt = SC[192 + cp], s1 = SC[cp], s2 = SC[64 + cp];
            const float v0 = bf_lo(vv.x), v1 = bf_hi(vv.x), v2 = bf_lo(vv.y), v3 = bf_hi(vv.y);
            LAS bf16_t* RH = (LAS bf16_t*)(lds + SL_RH);
            RH[(dv0 + 0) * 72 + cp] = f2bf(v0 * bt - aT[0] * s1); RH[(dv0 + 1) * 72 + cp] = f2bf(v1 * bt - aT[1] * s1);
            RH[(dv0 + 2) * 72 + cp] = f2bf(v2 * bt - aT[2] * s1); RH[(dv0 + 3) * 72 + cp] = f2bf(v3 * bt - aT[3] * s1);
            qs = aQ * s2; }
        SCAN_BAR();
        if (act) {
            f32x4 acc = {0.f, 0.f, 0.f, 0.f};
#pragma unroll
            for (int ks = 0; ks < 2; ++ks) { const bf16x8 a = *(const LAS bf16x8*)(lds + SL_RH + ((16 * tm + l15) * 72 + 32 * ks + 8 * l4) * 2);
                const bf16x8 b = *(const LAS bf16x8*)(B + SB_TI + ((16 * tn + l15) * 72 + 32 * ks + 8 * l4) * 2); acc = mfma16(a, b, acc); }
            const float s3 = SC[128 + cp];
            LAS bf16_t* VN = (LAS bf16_t*)(lds + SL_VN); LAS bf16_t* VS = (LAS bf16_t*)(lds + SL_VS);
#pragma unroll
            for (int r = 0; r < 4; ++r) { VN[(dv0 + r) * 72 + cp] = f2bf(acc[r]); VS[(dv0 + r) * 72 + cp] = f2bf(acc[r] * s3); } }
        SCAN_BAR();
        if (more) SC_SCAL(cur ^ 1);
        if (act) {
            f32x4 acc = qs;
#pragma unroll
            for (int ks = 0; ks < 2; ++ks) { const bf16x8 a = *(const LAS bf16x8*)(lds + SL_VN + ((16 * tm + l15) * 72 + 32 * ks + 8 * l4) * 2);
                const bf16x8 b = *(const LAS bf16x8*)(B + SB_AT + ((16 * tn + l15) * 72 + 32 * ks + 8 * l4) * 2); acc = mfma16(a, b, acc); }
            const int cgi = c0g + (d ? N - 1 - n : n); const int row = cgi * 64 + (d ? 63 - cp : cp);
            u32x2 w; w.x = cvt_pk(acc[0], acc[1]); w.y = cvt_pk(acc[2], acc[3]);
            *(u32x2*)(OD + ((size_t)((d * 4 + h) * 4 + v_slab) * M_TOK + row) * 32 + v_col + dv0) = w; }
        {
          const float egl = SC[256];
#pragma unroll
          for (int t = 0; t < NDT; ++t) Sx[t] = Sx[t] * egl;
#pragma unroll
          for (int ks = 0; ks < 2; ++ks) { const bf16x8 a = *(const LAS bf16x8*)(lds + SL_VS + ((16 * sdv + l15) * 72 + 32 * ks + 8 * l4) * 2);
#pragma unroll
              for (int t = 0; t < NDT; ++t) {
                  const LAS bf16_t* kc0 = (const LAS bf16_t*)B + (32 * ks + 8 * l4) * 136 + 16 * (sdk0 + t) + l15;
                  u32x4 g0;
                  g0.x = (unsigned)kc0[0] | ((unsigned)kc0[136] << 16); g0.y = (unsigned)kc0[272] | ((unsigned)kc0[408] << 16); g0.z = (unsigned)kc0[544] | ((unsigned)kc0[680] << 16); g0.w = (unsigned)kc0[816] | ((unsigned)kc0[952] << 16);
                  Sx[t] = mfma16(a, __builtin_bit_cast(bf16x8, g0), Sx[t]); } }
          LAS bf16_t* ST = (LAS bf16_t*)(lds + SL_ST);
#pragma unroll
          for (int t = 0; t < NDT; ++t)
#pragma unroll
              for (int r = 0; r < 4; ++r) ST[(16 * sdv + 4 * l4 + r) * 136 + 16 * (sdk0 + t) + l15] = f2bf(Sx[t][r]); }
        asm volatile("s_waitcnt vmcnt(0)" ::: "memory"); SCAN_BAR();
    }
    SCAN_BAR();
#undef SC_DMA
#undef SC_SCAL
}


#define XB_TMO      128
#define XB_XCNT(j)  (256  + 64 * (j))
#define XB_XSUB(j)  (1280 + 64 * (j))
#define XB_XGEN(j)  (2304 + 64 * (j))
#define XB_TOP      3328
#define XB_TOPGEN   3392
#define XCD_BAR_WORDS 3456
#define XB_SPIN_CAP (1u << 18)

__device__ __forceinline__ unsigned xb_ld(unsigned* p)              { return __hip_atomic_load(p, __ATOMIC_RELAXED, __HIP_MEMORY_SCOPE_AGENT); }
__device__ __forceinline__ unsigned xb_add(unsigned* p, unsigned v) { return __hip_atomic_fetch_add(p, v, __ATOMIC_RELAXED, __HIP_MEMORY_SCOPE_AGENT); }
__device__ __forceinline__ unsigned xb_xcc_id() { return (unsigned)__builtin_amdgcn_s_getreg((3 << 11) | 20) & 0xFu; }
#define XB_SPIN(cond, bar) do { unsigned _sp = 0; while (cond) { __builtin_amdgcn_s_sleep(1); \
    if ((++_sp & 255u) == 0u) { if (xb_ld(&(bar)[XB_TMO])) break; if (_sp > XB_SPIN_CAP) { atomicAdd(&(bar)[XB_TMO], 1u); break; } } } } while (0)

struct XcdBarrier {
    unsigned* bar; unsigned x;
    volatile LAS unsigned* st;
};

__device__ __forceinline__ XcdBarrier xcd_barrier_post(unsigned* bar, volatile LAS unsigned* st) {
    XcdBarrier b; b.bar = bar; b.x = xb_xcc_id(); b.st = st;
    if (threadIdx.x == 0) (void)xb_add(&bar[XB_XCNT(b.x)], 1u);
    return b;
}
__device__ __forceinline__ void xcd_barrier_complete(unsigned* bar, unsigned x, unsigned& nloc, unsigned& nx) {
    const unsigned G = gridDim.x * gridDim.y * gridDim.z;
    unsigned sum, cnt, mine, sp = 0u;
    for (;;) {
        sum = 0u; cnt = 0u; mine = 0u;
#pragma unroll
        for (unsigned j = 0; j < 16; ++j) { const unsigned c = xb_ld(&bar[XB_XCNT(j)]); sum += c; cnt += (c > 0u) ? 1u : 0u; mine = (j == x) ? c : mine; }
        if (sum == G) break;
        __builtin_amdgcn_s_sleep(1);
        if ((++sp & 255u) == 0u) { if (xb_ld(&bar[XB_TMO])) break; if (sp > XB_SPIN_CAP) { atomicAdd(&bar[XB_TMO], 1u); break; } }
    }
    nloc = mine > 0u ? mine : 1u; nx = cnt > 0u ? cnt : 1u;
}

__device__ __forceinline__ void xcd_barrier(const XcdBarrier& b) {
    asm volatile("s_waitcnt vmcnt(0)" ::: "memory");
    __syncthreads();
    if (threadIdx.x == 0) {
        unsigned* bar = b.bar;
        __builtin_amdgcn_s_waitcnt(0);
        unsigned nloc = b.st[0], nx = b.st[1];
        if (nloc == 0u) { xcd_barrier_complete(bar, b.x, nloc, nx); b.st[0] = nloc; b.st[1] = nx; }
        const unsigned old = xb_add(&bar[XB_XSUB(b.x)], 1u);
        const unsigned gen = old / nloc;
        if (old + 1u == (gen + 1u) * nloc) {
            __builtin_amdgcn_fence(__ATOMIC_RELEASE, "agent");
            asm volatile("s_waitcnt vmcnt(0)" ::: "memory");
            const unsigned og = xb_add(&bar[XB_TOP], 1u);
            const unsigned tg = og / nx;
            if (og + 1u == (tg + 1u) * nx) xb_add(&bar[XB_TOPGEN], 1u);
            else XB_SPIN(xb_ld(&bar[XB_TOPGEN]) == tg, bar);
            __builtin_amdgcn_fence(__ATOMIC_ACQUIRE, "agent");
            xb_add(&bar[XB_XGEN(b.x)], 1u);
            asm volatile("s_waitcnt vmcnt(0)" ::: "memory");
        } else {
            XB_SPIN(xb_ld(&bar[XB_XGEN(b.x)]) == gen, bar);
            __builtin_amdgcn_fence(__ATOMIC_ACQUIRE, "agent");
            asm volatile("s_waitcnt vmcnt(0)" ::: "memory");
        }
    }
    __syncthreads();
}

constexpr int NPHASE = 14;
constexpr int LDS_BYTES = 163840, LDS_MISC = 157696;
struct Args { const float* in[25]; float* out; unsigned char* ws; int ph_lo, ph_hi; };

__global__ void __launch_bounds__(512, 2) fwd_kernel(Args a) {
    extern __shared__ __attribute__((aligned(16))) unsigned char lds_raw[];
    LAS unsigned char* lds = (LAS unsigned char*)lds_raw;
    cg::grid_group grid = cg::this_grid();
    const int tid = threadIdx.x, lane = tid & 63, wave = __builtin_amdgcn_readfirstlane(tid >> 6);
    const int G = gridDim.x, bid = blockIdx.x;
    const int gw = bid * 8 + wave, NGW = G * 8;
    unsigned char* ws = a.ws; unsigned char* dob = (unsigned char*)a.out;
    const float* xp = a.in[0]; const float* xs = a.in[1];
    bf16_t* Win_t = (bf16_t*)(ws + WS_WIN); bf16_t* Wuq_t = (bf16_t*)(ws + WS_WUQ); bf16_t* Wukv_t = (bf16_t*)(ws + WS_WUKV);
    bf16_t* Wout_t = (bf16_t*)(ws + WS_WOUT); bf16_t* W1_t = (bf16_t*)(ws + WS_W1); bf16_t* W2_t = (bf16_t*)(ws + WS_W2);
    float* mod = (float*)(ws + WS_MOD); float* modf_ = (float*)(ws + WS_MODF); float* rsq = (float*)(ws + WS_RSQ); float* rskv = (float*)(ws + WS_RSKV);
    float* gates = (float*)(ws + WS_GATES);
    bf16_t* R1 = (bf16_t*)(ws + WS_R1); bf16_t* TINV = (bf16_t*)(ws + WS_TINV); bf16_t* ATT = (bf16_t*)(ws + WS_ATT);
    bf16_t* bufQKV = (bf16_t*)(ws + WS_R2); bf16_t* OD = (bf16_t*)(ws + WS_R2); bf16_t* HID = (bf16_t*)dob;          bf16_t* X1 = (bf16_t*)(ws + WS_R2);
    bf16_t* bufZ = (bf16_t*)(ws + WS_Z); bf16_t* bufA = (bf16_t*)(ws + WS_A);
    bf16_t* GQ = (bf16_t*)(dob + DO_GQ); bf16_t* GK = (bf16_t*)(dob + DO_GK); bf16_t* GV = (bf16_t*)(dob + DO_GV); bf16_t* KT = (bf16_t*)(dob + DO_KT);
    bf16_t* Qb = (bf16_t*)(dob + DO_Q); bf16_t* KVP = (bf16_t*)(dob + DO_KVP); bf16_t* KVS = (bf16_t*)(ws + WS_KVS);
    const int lo = a.ph_lo, hi = a.ph_hi;
    volatile LAS unsigned* MISC = (volatile LAS unsigned*)(lds + LDS_MISC);
    if (tid < 16) MISC[tid] = 0u;
    __syncthreads();
    unsigned* ctl = (unsigned*)(ws + WS_CTL);
    XcdBarrier xbar = xcd_barrier_post(ctl, MISC + 8);
    if (a.ph_lo < 0) grid.sync();
#ifndef PH_MASK
#define PH_MASK 0xFFFF
#endif
#define IN(k) (((PH_MASK >> (k)) & 1) && lo <= (k) && (k) < hi)
#define SEAM(k) do { if (IN((k) + 1)) xcd_barrier(xbar); } while (0)

#define KV_GEMM(half, Gx, cx) do { pg8::Gemm g_{bufA + 384 + (size_t)(half) * 32768 * 768, Wukv_t, 32768, 1024, 256, 768}; pg8::StaticOrder S_; S_.init(32768, 1024, (Gx), (cx)); \
        pg8::EpiBf16<0> E_{(half) ? KVS : KVP, 1024, rskv + (half) * 32768, 1.f}; pg8::gemm_phase<pg8::EpiBf16<0>, pg8::StaticOrder, true>(lds, g_, S_, E_); } while (0)
    constexpr int I_IN = 16 * 88, I_UQ = 6 * 24, I_UKV = 4 * 32, I_OUT = 16 * 32, I_1 = 16 * 128, I_2 = 64 * 32;
    if (IN(0)) {
        LAS float* scs = (LAS float*)lds;
        LAS float* red = (LAS float*)(lds + 24576);
        for (int i = tid; i < 6 * 1024; i += 512) { const int b = i >> 10, k = i & 1023; const float c = b < 2 ? a.in[2][b * 1024 + k] : a.in[3][(b - 2) * 1024 + k]; scs[i] = siluf(c); }
        __syncthreads();
        for (int it = bid; it < 256; it += G) {
            const bool fin = it >= 192; const float* W = fin ? a.in[22] : a.in[4]; const float* bias = fin ? a.in[23] : a.in[5];
            const int N = fin ? 2048 : 6144, n0 = (fin ? it - 192 : it) * 32, col = tid & 31, ksl = tid >> 5;
            float acc[6] = {0.f, 0.f, 0.f, 0.f, 0.f, 0.f};
#pragma unroll 8
            for (int kk = 0; kk < 64; ++kk) { const int k = ksl * 64 + kk; const float w = W[(size_t)k * N + n0 + col];
#pragma unroll
                for (int b = 0; b < 6; ++b) acc[b] += scs[b * 1024 + k] * w; }
#pragma unroll
            for (int b = 0; b < 6; ++b) red[(ksl * 6 + b) * 32 + col] = acc[b];
            __syncthreads();
            if (tid < 192) { const int b = tid >> 5; float s = bias[n0 + col];
#pragma unroll
                for (int q = 0; q < 16; ++q) s += red[(q * 6 + b) * 32 + col];
                (fin ? modf_ : mod)[(size_t)b * N + n0 + col] = s; }
            __syncthreads();
        }
        SEAM(0);
    }
    if (IN(1)) {
        LAS float* scr = (LAS float*)(lds + wave * 8448);
        for (int it = gw; it < (G == 256 ? I_IN + I_UQ + I_UKV : I_IN + I_UQ + I_UKV + I_OUT + I_1 + I_2); it += NGW) {
            int r = it;
            if (r < I_IN) { transpose_item(a.in[7], 1024, 2768, N_IN, Win_t, nullptr, 1, scr, r, lane); continue; } r -= I_IN;
            if (r < I_UQ) { transpose_item(a.in[9], 384, 768, 768, Wuq_t, a.in[8], 2, scr, r, lane); continue; } r -= I_UQ;
            if (r < I_UKV) { transpose_item(a.in[11], 256, 1024, 1024, Wukv_t, a.in[10], 0, scr, r, lane); continue; } r -= I_UKV;
            if (r < I_OUT) { transpose_item(a.in[18], 1024, 1024, 1024, Wout_t, nullptr, 0, scr, r, lane); continue; } r -= I_OUT;
            if (r < I_1) { transpose_item(a.in[20], 1024, 4096, 4096, W1_t, nullptr, 0, scr, r, lane); continue; } r -= I_1;
            transpose_item(a.in[21], 4096, 1024, 1024, W2_t, nullptr, 0, scr, r, lane);
        }
        for (int m = gw; m < M_TOK; m += 2 * NGW) { const int m1 = (m + NGW < M_TOK) ? m + NGW : m;
            const float* xr0 = m < 32768 ? xp + (size_t)m * DM : xs + (size_t)(m - 32768) * DM; const float* xr1 = m1 < 32768 ? xp + (size_t)m1 * DM : xs + (size_t)(m1 - 32768) * DM;
            const float* md0 = mod + (size_t)seq_of_row(m) * 6144; const float* md1 = mod + (size_t)seq_of_row(m1) * 6144;
            norm_mod_row2<true>(xr0, xr1, a.in[6], md0 + 1024, md0, md1 + 1024, md1, R1 + (size_t)m * DM, R1 + (size_t)m1 * DM, lane); }
        SEAM(1);
    }
    if (IN(2)) {
#if ENABLE_MLA || ENABLE_GDN
        pg8::Gemm g{R1, Win_t, M_TOK, N_IN, 1024, 1024}; pg8::StaticOrder S; S.init(M_TOK, N_IN, G, bid);
        pg8::EpiProj E{bufA, bufQKV, bufZ};
        pg8::gemm_phase<pg8::EpiProj, pg8::StaticOrder, true>(lds, g, S, E);
#endif
        SEAM(2);
    }
    if (IN(3)) {
#if ENABLE_MLA || ENABLE_GDN
        for (int m = gw; m < M_TOK; m += NGW) {
            const unsigned* rowp = (const unsigned*)(bufA + (size_t)m * 768);
            float s = 0.f;
#pragma unroll
            for (int j = 0; j < 3; ++j) { const unsigned w = rowp[lane + 64 * j]; const float x0 = bf_lo(w), x1 = bf_hi(w); s += x0 * x0 + x1 * x1; }
            s = wave_sum(s);
            float s2 = 0.f;
#pragma unroll
            for (int j = 0; j < 2; ++j) { const unsigned w = rowp[192 + lane + 64 * j]; const float x0 = bf_lo(w), x1 = bf_hi(w); s2 += x0 * x0 + x1 * x1; }
            s2 = wave_sum(s2);
            if (lane == 0) { rsq[m] = rsqrtf(s * (1.f / 384.f) + EPS); rskv[m] = rsqrtf(s2 * (1.f / 256.f) + EPS); }
            const int pos = m - seq_start(seq_of_row(m));
            const bf16_t* kr = bufA + (size_t)m * 768 + 640;
            unsigned ow = 0;
            if (lane < 32) { const float x1 = bf1(kr[lane]), x2 = bf1(kr[lane + 32]); const double rev = (double)pos * c_invrev[lane]; const float fr_ = (float)(rev - rint(rev));
                const float sn = __builtin_amdgcn_sinf(fr_), cs = __builtin_amdgcn_cosf(fr_); ow = cvt_pk(x1 * cs - x2 * sn, x2 * cs + x1 * sn); }
            float gv = 0.f;
            if (lane < 8) { float g_, b_; gate_vals(bufA, m, lane >> 2, lane & 3, a.in[13], a.in[14], a.in[15], a.in[16], g_, b_); gv = g_; gates[(size_t)m * 16 + 8 + lane] = b_; }
            (void)gv;
            asm volatile("s_waitcnt vmcnt(0)" ::: "memory");
            if (lane < 32) ((unsigned*)(bufA + (size_t)m * 768 + 640))[lane] = ow;
        }
#endif
#if ENABLE_GDN
        __syncthreads();
        for (int it = bid; it < 4096; it += G) gdn_prep_item(it >> 2, it & 3, lds, bufQKV, a.in[12], bufA, a.in[13], a.in[14], a.in[15], a.in[16], GQ, GK, GV, KT, TINV, ATT, gates);
#endif
        SEAM(3);
    }
    if (IN(4)) {
#if ENABLE_GDN
#if GDN_DBG == 2
        for (int m = gw; m < M_TOK; m += NGW) { const int hh = lane >> 4, cgx = m >> 6, ii = m & 63;
            for (int e = 0; e < 8; ++e) { const size_t o = (size_t)m * 512 + lane * 8 + e; const int dd = e & 1;
                OD[o] = f2bf(bf1(GQ[o]) + bf1(GK[o]) + bf1(GV[o]) + gates[(size_t)m * 16 + (lane & 15)]);
                const size_t tb = ((size_t)((cgx * 4 + hh) * 2 + dd) * 64 + ii) * 64 + (lane & 15) * 4 + (e >> 1);
                OD[(size_t)M_TOK * 512 + o] = f2bf(bf1(TINV[tb]) + bf1(ATT[tb]) + bf1(KT[((size_t)(cgx * 4 + hh) * 128 + (lane & 15) * 8 + e) * 64 + ii])); } }
#else
        if (G == 256) {
            const int xcd = bid & 7, li = bid >> 3;
            if (li < 16) gdn_scan_chain<16>((li >> 3) * 8 + xcd, li & 7, lds, gates, GQ, GK, GV, TINV, ATT, OD);
            else { gdn_scan_chain<32>(16 + ((li - 16) >> 2) * 8 + xcd, (li - 16) & 3, lds, gates, GQ, GK, GV, TINV, ATT, OD);
#if ENABLE_MLA
                const int cx = (li - 16) * 8 + xcd; KV_GEMM(0, 128, cx); KV_GEMM(1, 128, cx);
#endif
                {
                  LAS float* scr = (LAS float*)(lds + wave * 8448); const int hw = ((li - 16) * 8 + xcd) * 8 + wave;
                  for (int r = hw; r < I_OUT + I_1 + I_2; r += 1024) {
                      if (r < I_OUT) transpose_item(a.in[18], 1024, 1024, 1024, Wout_t, nullptr, 0, scr, r, lane);
                      else if (r < I_OUT + I_1) transpose_item(a.in[20], 1024, 4096, 4096, W1_t, nullptr, 0, scr, r - I_OUT, lane);
                      else transpose_item(a.in[21], 4096, 1024, 1024, W2_t, nullptr, 0, scr, r - I_OUT - I_1, lane); } }
            }
        } else
        for (int ch = bid; ch < 192; ch += G) gdn_scan_chain<32>(ch >> 2, ch & 3, lds, gates, GQ, GK, GV, TINV, ATT, OD);
#endif
#endif
        SEAM(4);
    }
    if (IN(5)) {
        for (int m0 = gw; m0 < M_TOK; m0 += 2 * NGW) {
            u32x4 ofv[2], obv[2], zvv[2]; int mr[2];
#pragma unroll
            for (int k = 0; k < 2; ++k) { mr[k] = (m0 + k * NGW < M_TOK) ? m0 + k * NGW : m0;
#if ENABLE_GDN
                { const size_t oo = ((size_t)((lane >> 4) * 4 + ((lane & 15) >> 2)) * M_TOK + mr[k]) * 32 + (lane & 3) * 8;
                  ofv[k] = *(const u32x4*)(OD + oo); obv[k] = *(const u32x4*)(OD + (size_t)16 * M_TOK * 32 + oo); }
                zvv[k] = *(const u32x4*)(bufZ + (size_t)mr[k] * 512 + lane * 8);
#endif
            }
            const f32x4 g0 = *(const f32x4*)(a.in[17] + (lane & 15) * 8), g1 = *(const f32x4*)(a.in[17] + (lane & 15) * 8 + 4);
            const float gg[8] = {g0[0], g0[1], g0[2], g0[3], g1[0], g1[1], g1[2], g1[3]};
#pragma unroll
            for (int k = 0; k < 2; ++k) {
                u32x4 ov = {0u, 0u, 0u, 0u};
#if ENABLE_GDN
                const u32x4 of = ofv[k], ob = obv[k], zv = zvv[k];
                float o[8] = {bf_lo(of.x) + bf_lo(ob.x), bf_hi(of.x) + bf_hi(ob.x), bf_lo(of.y) + bf_lo(ob.y), bf_hi(of.y) + bf_hi(ob.y),
                              bf_lo(of.z) + bf_lo(ob.z), bf_hi(of.z) + bf_hi(ob.z), bf_lo(of.w) + bf_lo(ob.w), bf_hi(of.w) + bf_hi(ob.w)};
                const float z[8] = {bf_lo(zv.x), bf_hi(zv.x), bf_lo(zv.y), bf_hi(zv.y), bf_lo(zv.z), bf_hi(zv.z), bf_lo(zv.w), bf_hi(zv.w)};
                float ss = 0.f;
#pragma unroll
                for (int e = 0; e < 8; ++e) ss += o[e] * o[e];
                ss = row16_sum(ss);
                const float rstd = rsqrtf(ss * (1.f / 128.f) + EPS);
#pragma unroll
                for (int e = 0; e < 8; ++e) o[e] = o[e] * rstd * gg[e] * siluf(z[e]);
                ov.x = cvt_pk(o[0], o[1]); ov.y = cvt_pk(o[2], o[3]); ov.z = cvt_pk(o[4], o[5]); ov.w = cvt_pk(o[6], o[7]);
#endif
                *(u32x4*)(R1 + (size_t)mr[k] * DM + 512 + lane * 8) = ov;
#if !ENABLE_MLA
                *(u32x4*)(R1 + (size_t)mr[k] * DM + lane * 8) = (u32x4){0u, 0u, 0u, 0u};
#endif
            }
        }
#if ENABLE_MLA
        __syncthreads();
        { pg8::Gemm g{bufA, Wuq_t, M_TOK, 768, 384, 768}; pg8::StaticOrder S; S.init(M_TOK, 768, G, bid);
          pg8::EpiBf16<0> E{Qb, 768, rsq, QSCALE};
          pg8::gemm_phase<pg8::EpiBf16<0>, pg8::StaticOrder, true>(lds, g, S, E); }
        if (G != 256) { KV_GEMM(0, G, bid); KV_GEMM(1, G, bid); }
#endif
        SEAM(5);
    }
    if (IN(6)) {
#if ENABLE_MLA
        const int vcu = (G % 8 == 0) ? (bid % 8) * (G / 8) + bid / 8 : bid;
        for (int rep_ = 0; rep_ < ATT_REP; ++rep_)
        for (int u = vcu; u < 1024; u += G) {
            int sq, h, qb;
            if (u < 512) { sq = u >> 8; h = (u >> 6) & 3; qb = u & 63; } else { const int v = u - 512; sq = 2 + (v >> 7); h = (v >> 5) & 3; qb = v & 31; }
            const int s0 = seq_start(sq), sl = seq_len(sq); const size_t q0 = (size_t)s0 + qb * 256;
            const bf16_t* kvb = (sq < 2 ? KVP + (size_t)s0 * 1024 : KVS + (size_t)(s0 - 32768) * 1024) + h * 256;
            att::attn_unit(Qb + q0 * 768 + h * 192, kvb, kvb + 128, bufA + (size_t)s0 * 768 + 640,
                           R1 + q0 * DM + h * 128, sl, qb * 256, (char*)lds_raw);
        }
#endif
        SEAM(6);
    }
    if (IN(7)) {
        pg8::Gemm g{R1, Wout_t, M_TOK, DM, 1024, 1024}; pg8::StaticOrder S; S.init(M_TOK, DM, G, bid);
        pg8::EpiResB<0> E{xp, xs, X1, mod + 2048, 0};
        pg8::gemm_phase<pg8::EpiResB<0>, pg8::StaticOrder, true>(lds, g, S, E);
        SEAM(7);
    }
    if (IN(8)) {
        for (int m = gw; m < M_TOK; m += 2 * NGW) norm_rows_b<true>(m, NGW, X1, a.in[19], mod, 6144, 4096, 3072, R1, nullptr, lane);
        SEAM(8);
    }
#pragma unroll 1
    for (int half = 0; half < 2; ++half) {
        if (IN(9 + 2 * half)) {
            pg8::Gemm g{R1 + (size_t)half * 32768 * DM, W1_t, 32768, FF, 1024, 1024}; pg8::StaticOrder S; S.init(32768, FF, G, bid);
            pg8::EpiBf16<1> E{HID, FF, nullptr, 1.f};
            pg8::gemm_phase<pg8::EpiBf16<1>, pg8::StaticOrder, true>(lds, g, S, E);
            SEAM(9 + 2 * half);
        }
        if (IN(10 + 2 * half)) {
            pg8::Gemm g{HID, W2_t, 32768, DM, FF, FF}; pg8::StaticOrder S; S.init(32768, DM, G, bid);
            pg8::EpiResB<1> E{xp, xs, X1, mod + 5120, half * 32768};
            pg8::gemm_phase<pg8::EpiResB<1>, pg8::StaticOrder, true>(lds, g, S, E);
            SEAM(10 + 2 * half);
        }
    }
    if (IN(13)) {
        for (int m = gw; m < M_TOK; m += 2 * NGW) norm_rows_b<false>(m, NGW, X1, a.in[24], modf_, 2048, 1024, 0, nullptr, a.out, lane);
    }
#undef IN
#undef SEAM
}

extern "C" void kernel_launch(void* const* d_in, const int* in_sizes, int n_in, void* d_out, int out_size, void* d_ws, size_t ws_size, hipStream_t stream) {
    static int grid = 0;
    if (grid == 0) {
        if (n_in != 25 || out_size != M_TOK * DM || ws_size < WS_END) { fprintf(stderr, "kernel_launch: unexpected shapes (n_in %d out %d ws %zu)\n", n_in, out_size, ws_size); grid = -1; return; }
        int dev = 0, cus = 0, per_cu = 0;
        hipGetDevice(&dev); hipDeviceGetAttribute(&cus, hipDeviceAttributeMultiprocessorCount, dev);
        if (hipFuncSetAttribute((const void*)fwd_kernel, hipFuncAttributeMaxDynamicSharedMemorySize, LDS_BYTES) != hipSuccess) { fprintf(stderr, "kernel_launch: hipFuncSetAttribute failed\n"); grid = -1; return; }
        if (hipOccupancyMaxActiveBlocksPerMultiprocessor(&per_cu, (const void*)fwd_kernel, 512, LDS_BYTES) != hipSuccess || per_cu < 1) { fprintf(stderr, "kernel_launch: occupancy query says %d\n", per_cu); per_cu = 1; }
        (void)hipGetLastError();
        grid = cus * 1;
    }
    if (grid < 0) return;
    if (hipMemsetAsync((char*)d_ws + WS_CTL, 0, CTL_BYTES, stream) != hipSuccess) { fprintf(stderr, "kernel_launch: memset failed\n"); return; }
    Args a{};
    for (int i = 0; i < 25; ++i) a.in[i] = (const float*)d_in[i];
    a.out = (float*)d_out; a.ws = (unsigned char*)d_ws;
#if N_LAUNCH_MODE == 1
    const int cuts[2] = {0, NPHASE}; const int nl = 1;
#else
    int cuts[NPHASE + 1]; for (int i = 0; i <= NPHASE; ++i) cuts[i] = i; const int nl = NPHASE;
#endif
    for (int li = 0; li < nl; ++li) {
        a.ph_lo = cuts[li]; a.ph_hi = cuts[li + 1];
        void* args[] = {&a};
        const hipError_t e = hipLaunchCooperativeKernel((const void*)fwd_kernel, dim3(grid), dim3(512), args, LDS_BYTES, stream);
        if (e != hipSuccess) { fprintf(stderr, "kernel_launch: cooperative launch %d failed: %s (grid %d)\n", li, hipGetErrorString(e), grid); break; }
    }
}
```

```cpp
#include <hip/hip_runtime.h>
#include <hip/hip_cooperative_groups.h>
#include <cstdio>
#include <cstdint>
#include <cmath>
namespace cg = cooperative_groups;

#ifndef N_LAUNCH_MODE
#define N_LAUNCH_MODE 1
#endif
#ifndef ATT_REP
#define ATT_REP 1
#endif
#ifndef SCAN_REP
#define SCAN_REP 1
#endif
#ifndef GDN_DBG
#define GDN_DBG 0
#endif
#ifndef ENABLE_MLA
#define ENABLE_MLA 1
#endif
#ifndef ENABLE_GDN
#define ENABLE_GDN 1
#endif

#define LAS __attribute__((address_space(3)))
typedef unsigned short bf16_t;
typedef short bf16x8 __attribute__((ext_vector_type(8)));
typedef short bf16x4 __attribute__((ext_vector_type(4)));
typedef float f32x4 __attribute__((ext_vector_type(4)));
typedef float f32x2 __attribute__((ext_vector_type(2)));
typedef unsigned u32x4 __attribute__((ext_vector_type(4)));
typedef unsigned u32x2 __attribute__((ext_vector_type(2)));

constexpr int M_TOK = 65536, DM = 1024, NSEQ = 6, FF = 4096;
constexpr int N_IN = 2816;
constexpr float EPS = 1e-6f;
constexpr float QSCALE = 0.07216878364870322f * 1.4426950408889634f;
constexpr float DKS = 0.08838834764831845f;

__device__ __forceinline__ int seq_of_row(int r) { return r < 32768 ? (r >> 14) : 2 + ((r - 32768) >> 13); }
__device__ __forceinline__ int seq_start(int s) { return s < 2 ? s * 16384 : 32768 + (s - 2) * 8192; }
__device__ __forceinline__ int seq_len(int s) { return s < 2 ? 16384 : 8192; }

constexpr size_t MiB = 1u << 20;
constexpr size_t WS_WIN = 0, WS_WUQ = 6 * MiB, WS_WUKV = 7 * MiB, WS_WOUT = 8 * MiB, WS_W1 = 10 * MiB, WS_W2 = 18 * MiB;
constexpr size_t WS_MOD = 26 * MiB, WS_MODF = 26 * MiB + 256 * 1024, WS_RSQ = 26 * MiB + 512 * 1024, WS_RSKV = 26 * MiB + 768 * 1024;
constexpr size_t WS_CTL = 26 * MiB + 384 * 1024, CTL_BYTES = 65536;
constexpr size_t WS_GATES = 27 * MiB;
constexpr size_t WS_R1 = 32 * MiB;
constexpr size_t WS_TINV = WS_R1, WS_ATT = WS_R1 + 64 * MiB;
constexpr size_t WS_R2 = 160 * MiB;
constexpr size_t WS_Z = 352 * MiB;
constexpr size_t WS_A = 416 * MiB;
constexpr size_t WS_END = 512 * MiB;
constexpr size_t DO_GQ = 0, DO_GK = 64 * MiB, DO_GV = 128 * MiB, DO_KT = 192 * MiB;
constexpr size_t DO_Q = 0, DO_KVP = 192 * MiB, WS_KVS = 288 * MiB;

typedef __bf16 bf16x2_t __attribute__((ext_vector_type(2)));
__device__ __forceinline__ unsigned cvt_pk(float lo, float hi) { f32x2 v = {lo, hi}; bf16x2_t b = __builtin_convertvector(v, bf16x2_t); return __builtin_bit_cast(unsigned, b); }
__device__ __forceinline__ float bf_lo(unsigned w) { return __uint_as_float(w << 16); }
__device__ __forceinline__ float bf_hi(unsigned w) { return __uint_as_float(w & 0xffff0000u); }
__device__ __forceinline__ float bf1(bf16_t h) { return __uint_as_float(((unsigned)h) << 16); }
__device__ __forceinline__ bf16_t f2bf(float f) { return (bf16_t)(cvt_pk(f, 0.f) & 0xffffu); }
__device__ __forceinline__ float wave_sum(float v) {
#pragma unroll
    for (int o = 1; o < 64; o <<= 1) v += __shfl_xor(v, o);
    return v;
}
__device__ __forceinline__ float siluf(float x) { return x / (1.f + __expf(-x)); }
__device__ __forceinline__ float row16_sum(float v) {
    v += __int_as_float(__builtin_amdgcn_update_dpp(0, __float_as_int(v), 0x128, 0xF, 0xF, false));
    v += __int_as_float(__builtin_amdgcn_update_dpp(0, __float_as_int(v), 0x124, 0xF, 0xF, false));
    v += __int_as_float(__builtin_amdgcn_update_dpp(0, __float_as_int(v), 0x122, 0xF, 0xF, false));
    v += __int_as_float(__builtin_amdgcn_update_dpp(0, __float_as_int(v), 0x121, 0xF, 0xF, false));
    return v;
}

__constant__ double c_invrev[32] = {0.15915494309189535, 0.11934937021124886, 0.08949940160889101, 0.06711508300522726, 0.050329212104487035, 0.03774158471741977, 0.0283021958306234, 0.02122365276477766, 0.015915494309189534, 0.011934937021124886, 0.008949940160889102, 0.006711508300522725, 0.005032921210448704, 0.003774158471741977, 0.00283021958306234, 0.0021223652764777662, 0.0015915494309189536, 0.0011934937021124885, 0.0008949940160889102, 0.0006711508300522726, 0.0005032921210448703, 0.00037741584717419774, 0.00028302195830623395, 0.0002122365276477766, 0.00015915494309189535, 0.00011934937021124886, 8.949940160889102e-05, 6.711508300522725e-05, 5.0329212104487035e-05, 3.774158471741978e-05, 2.8302195830623396e-05, 2.122365276477766e-05};
__device__ __forceinline__ void gate_vals(const bf16_t* bufA, int row, int d, int h, const float* alog_f, const float* alog_b, const float* dt_f, const float* dt_b, float& g, float& beta) {
    const float va = bf1(bufA[(size_t)row * 768 + 704 + d * 4 + h]), vb = bf1(bufA[(size_t)row * 768 + 712 + d * 4 + h]);
    const float alog = d ? alog_b[h] : alog_f[h], dt = d ? dt_b[h] : dt_f[h];
    const float z = va + dt; const float sp = fmaxf(z, 0.f) + log1pf(__expf(-fabsf(z)));
    g = -__expf(alog) * sp; beta = 1.f / (1.f + __expf(-vb));
}

namespace pg8 {
#define PG8_LAS __attribute__((address_space(3)))
constexpr int BM = 256, BK = 64, HALF = 128, HTB = HALF * BK * 2  , STAGE_BYTES = 8 * HTB, NXCD = 8, WGM = 8;

__host__ __device__ __forceinline__ int lds_byte(int r, int c) { const int st = (r >> 4) * 2 + (c >> 5), rr = r & 15, cc = c & 31, ob = rr * 64 + cc * 2; return st * 1024 + (ob ^ (((ob >> 9) & 1) << 5)); }
__host__ __device__ __forceinline__ void stage_rc(int b, int& R, int& C) { const int st = b / 1024, sb = b % 1024, swz = sb ^ (((sb >> 9) & 1) << 5); R = (st >> 1) * 16 + swz / 64; C = (st & 1) * 32 + (swz % 64) / 2; }
__host__ __device__ __forceinline__ int perm32(int rho) { const int n = rho >> 4, i = rho & 15; return 8 * (i >> 2) + 4 * n + (i & 3); }

struct Unit { int pm, pn; };
struct Gemm { const bf16_t* A; const bf16_t* Bt; int M, N, K, lda; };

struct StaticOrder {
    int nM, nN, nwg, G, c;
    __host__ __device__ void init(int M, int N, int G_, int c_) { nM = M / BM; nN = N / BM; nwg = nM * nN; G = G_; c = c_; }
    __host__ __device__ bool next(int i, Unit& u) const {
        const long L = (long)i * G + c; if (L >= nwg) return false;
        int wgid = (int)L; { const int q = nwg / NXCD, r = nwg % NXCD, xcd = wgid % NXCD, off = wgid / NXCD; wgid = (xcd < r ? xcd * (q + 1) : r * (q + 1) + (xcd - r) * q) + off; }
        const int nig = WGM * nN, gid = wgid / nig, fm = gid * WGM, gsz = (nM - fm) < WGM ? (nM - fm) : WGM;
        u.pm = fm + ((wgid % nig) % gsz); u.pn = (wgid % nig) / gsz; return true;
    }
    __device__ __forceinline__ void a_ready(const Unit&) const {}
    __device__ __forceinline__ void done(const Unit&) const {}
};


__device__ __forceinline__ u32x4 pack8(f32x4 v0, f32x4 v1) { u32x4 w; w.x = cvt_pk(v0[0], v0[1]); w.y = cvt_pk(v0[2], v0[3]); w.z = cvt_pk(v1[0], v1[1]); w.w = cvt_pk(v1[2], v1[3]); return w; }

struct EpiProj {
    static constexpr bool PERM = true, AFTER_DRAIN = false;
    bf16_t *bA, *bQ, *bZ;
    __device__ __forceinline__ void operator()(const f32x4 (&acc)[2][2][4][2], const Unit& u, int wr, int wc, int fr, int fq) const {
        const int row0 = u.pm * BM + wr * 64 + fr, cw = wc * 32 + 8 * fq;
        bf16_t* b0; bf16_t* b1; int ld;
        if (u.pn < 3) { ld = 768; b0 = bA + u.pn * 256 + cw; b1 = b0 + HALF; }
        else if (u.pn < 9) { ld = 128; b0 = bQ + (size_t)(2 * (u.pn - 3)) * M_TOK * 128 + cw; b1 = b0 + (size_t)M_TOK * 128; }
        else { ld = 512; b0 = bZ + (u.pn - 9) * 256 + cw; b1 = b0 + HALF; }
#pragma unroll
        for (int ai = 0; ai < 2; ++ai)
#pragma unroll
            for (int m = 0; m < 4; ++m) { const size_t ro = (size_t)(row0 + ai * HALF + m * 16) * ld;
                *(u32x4*)(b0 + ro) = pack8(acc[ai][0][m][0], acc[ai][0][m][1]); *(u32x4*)(b1 + ro) = pack8(acc[ai][1][m][0], acc[ai][1][m][1]); }
    }
};
template <int ACT> struct EpiBf16 {
    static constexpr bool PERM = true, AFTER_DRAIN = false;
    bf16_t* O; int ld; const float* rowscale; float mul;
    __device__ __forceinline__ void operator()(const f32x4 (&acc)[2][2][4][2], const Unit& u, int wr, int wc, int fr, int fq) const {
        const int row0 = u.pm * BM + wr * 64 + fr, col0 = u.pn * BM + wc * 32 + 8 * fq;
#pragma unroll
        for (int ai = 0; ai < 2; ++ai)
#pragma unroll
            for (int m = 0; m < 4; ++m) { const int row = row0 + ai * HALF + m * 16; bf16_t* rowp = O + (size_t)row * ld + col0; const float rs = rowscale ? rowscale[row] * mul : 1.f;
#pragma unroll
                for (int bj = 0; bj < 2; ++bj) { f32x4 v0 = acc[ai][bj][m][0], v1 = acc[ai][bj][m][1];
                    if (ACT == 1) {
#pragma unroll
                        for (int e = 0; e < 4; ++e) { const float a = fmaxf(v0[e], 0.f), b = fmaxf(v1[e], 0.f); v0[e] = a * a; v1[e] = b * b; } }
                    else { v0 = v0 * rs; v1 = v1 * rs; }
                    *(u32x4*)(rowp + bj * HALF) = pack8(v0, v1); } }
    }
};
template <int MODE> struct EpiResB {
    static constexpr bool PERM = true, AFTER_DRAIN = false;
    const float* xp; const float* xs; bf16_t* X1; const float* gate; int row_off;
    __device__ __forceinline__ void operator()(const f32x4 (&acc)[2][2][4][2], const Unit& u, int wr, int wc, int fr, int fq) const {
        const int rowt = row_off + u.pm * BM; const int col0 = u.pn * BM + wc * 32 + 8 * fq;
        const float* gp = gate + (size_t)seq_of_row(rowt) * 6144 + col0;
        f32x4 gv[2][2];
#pragma unroll
        for (int bj = 0; bj < 2; ++bj)
#pragma unroll
            for (int n = 0; n < 2; ++n) gv[bj][n] = *(const f32x4*)(gp + bj * HALF + n * 4);
#pragma unroll
        for (int ai = 0; ai < 2; ++ai) {
            f32x4 bv[4][2][2];
#pragma unroll
            for (int m = 0; m < 4; ++m) { const int row = rowt + wr * 64 + fr + ai * HALF + m * 16;
                if (MODE == 0) { const float* xr = row < 32768 ? xp + (size_t)row * DM : xs + (size_t)(row - 32768) * DM;
#pragma unroll
                    for (int bj = 0; bj < 2; ++bj)
#pragma unroll
                        for (int n = 0; n < 2; ++n) bv[m][bj][n] = *(const f32x4*)(xr + col0 + bj * HALF + n * 4); }
                else {
#pragma unroll
                    for (int bj = 0; bj < 2; ++bj) { const u32x4 w = *(const u32x4*)(X1 + (size_t)row * DM + col0 + bj * HALF);
                        bv[m][bj][0] = (f32x4){bf_lo(w.x), bf_hi(w.x), bf_lo(w.y), bf_hi(w.y)}; bv[m][bj][1] = (f32x4){bf_lo(w.z), bf_hi(w.z), bf_lo(w.w), bf_hi(w.w)}; } } }
            asm volatile("" ::: "memory");
#pragma unroll
            for (int m = 0; m < 4; ++m) { const int row = rowt + wr * 64 + fr + ai * HALF + m * 16;
#pragma unroll
                for (int bj = 0; bj < 2; ++bj) *(u32x4*)(X1 + (size_t)row * DM + col0 + bj * HALF) = pack8(bv[m][bj][0] + gv[bj][0] * acc[ai][bj][m][0], bv[m][bj][1] + gv[bj][1] * acc[ai][bj][m][1]); }
            asm volatile("" ::: "memory");
        }
    }
};
template <int MODE> struct EpiRes {
    static constexpr bool PERM = false, AFTER_DRAIN = false;
    const float* xp; const float* xs; float* out; const float* gate; int row_off;
    __device__ __forceinline__ void operator()(const f32x4 (&acc)[2][2][4][2], const Unit& u, int wr, int wc, int fr, int fq) const {
        const int rowt = row_off + u.pm * BM; const int col0 = u.pn * BM + wc * 32 + 4 * fq;
        const float* gp = gate + (size_t)seq_of_row(rowt) * 6144 + col0;
        f32x4 gv[2][2];
#pragma unroll
        for (int bj = 0; bj < 2; ++bj)
#pragma unroll
            for (int n = 0; n < 2; ++n) gv[bj][n] = *(const f32x4*)(gp + bj * HALF + n * 16);
#pragma unroll
        for (int ai = 0; ai < 2; ++ai) {
            f32x4 bv[4][2][2];
#pragma unroll
            for (int m = 0; m < 4; ++m) { const int row = rowt + wr * 64 + fr + ai * HALF + m * 16;
                const float* xr = MODE == 0 ? (row < 32768 ? xp + (size_t)row * DM : xs + (size_t)(row - 32768) * DM) : out + (size_t)row * DM;
#pragma unroll
                for (int bj = 0; bj < 2; ++bj)
#pragma unroll
                    for (int n = 0; n < 2; ++n) bv[m][bj][n] = *(const f32x4*)(xr + col0 + bj * HALF + n * 16); }
            asm volatile("" ::: "memory");
#pragma unroll
            for (int m = 0; m < 4; ++m) { const int row = rowt + wr * 64 + fr + ai * HALF + m * 16; float* orow = out + (size_t)row * DM;
#pragma unroll
                for (int bj = 0; bj < 2; ++bj)
#pragma unroll
                    for (int n = 0; n < 2; ++n) *(f32x4*)(orow + col0 + bj * HALF + n * 16) = bv[m][bj][n] + gv[bj][n] * acc[ai][bj][m][n]; }
            asm volatile("" ::: "memory");
        }
    }
};
template <class Epi, class Sched, bool ALIGN_EPI = false>
__device__ __forceinline__ void gemm_phase(PG8_LAS unsigned char* lds, const Gemm g, const Sched& S, const Epi& E) {
    int tid_ = threadIdx.x; asm volatile("" : "+v"(tid_));
    const int tid = tid_, wid = __builtin_amdgcn_readfirstlane(tid >> 6), lane = tid & 63, wr = wid >> 2, wc = wid & 3, fr = lane & 15, fq = lane >> 4;
    const int K = g.K, nt = K / BK;
    unsigned voffA[2], voffB[2];
#pragma unroll
    for (int i = 0; i < 2; ++i) { int R, C; stage_rc(tid * 16 + i * 8192, R, C); const int Rb = Epi::PERM ? ((R & ~31) + perm32(R & 31)) : R;
        voffA[i] = (unsigned)(R * g.lda + C) * 2u; voffB[i] = (unsigned)(Rb * K + C) * 2u; }
    const size_t kstep = (size_t)(BK * 2);
    const size_t hstepA = (size_t)HALF * g.lda * 2, hstepB = (size_t)HALF * K * 2;
    const size_t tstepA = 2 * hstepA, tstepB = 2 * hstepB;
    const unsigned ldsw = (unsigned)wid * 1024u;
    const int aoff = lds_byte(wr * 64 + fr, fq * 8), boff = lds_byte(wc * 32 + fr, fq * 8);
#define PG8_SA(b, h) (((b) * 2 + (h)) * HTB)
#define PG8_SB(b, h) ((4 + (b) * 2 + (h)) * HTB)
#define PG8_STAGE(bufoff, gbase, voff) do { _Pragma("unroll") for (int _i = 0; _i < 2; ++_i) \
        __builtin_amdgcn_global_load_lds((const unsigned*)((const char*)(gbase) + (voff)[_i]), (PG8_LAS unsigned*)(lds + (bufoff) + ldsw + _i * 8192), 16, 0, 0); } while (0)
#define PG8_LDA(dst, b, h) do { _Pragma("unroll") for (int m = 0; m < 4; ++m) _Pragma("unroll") for (int k = 0; k < 2; ++k) dst[m][k] = *(const PG8_LAS bf16x8*)(lds + PG8_SA(b, h) + aoff + m * 2048 + k * 1024); } while (0)
#define PG8_LDB(dst, b, h) do { _Pragma("unroll") for (int n = 0; n < 2; ++n) _Pragma("unroll") for (int k = 0; k < 2; ++k) dst[n][k] = *(const PG8_LAS bf16x8*)(lds + PG8_SB(b, h) + boff + n * 2048 + k * 1024); } while (0)
#define PG8_MMA(ai, bj, At, Bt) do { __builtin_amdgcn_s_setprio(1); _Pragma("unroll") for (int m = 0; m < 4; ++m) _Pragma("unroll") for (int n = 0; n < 2; ++n) _Pragma("unroll") for (int k = 0; k < 2; ++k) \
        acc[ai][bj][m][n] = __builtin_amdgcn_mfma_f32_16x16x32_bf16(Bt[n][k], At[m][k], acc[ai][bj][m][n], 0, 0, 0); __builtin_amdgcn_s_setprio(0); } while (0)
#define PG8_WAIT_V(n) asm volatile("s_waitcnt vmcnt(" #n ")" ::: "memory")
#define PG8_WAIT_L(n) asm volatile("s_waitcnt lgkmcnt(" #n ")" ::: "memory")
#define PG8_BAR __builtin_amdgcn_s_barrier()
#define PG8_SCHED __builtin_amdgcn_sched_barrier(0)
    Unit cur, nxt; int ui = 0;
    if (!S.next(0, cur)) return;
    f32x4 acc[2][2][4][2];
#pragma unroll
    for (int a = 0; a < 2; ++a)
#pragma unroll
        for (int b = 0; b < 2; ++b)
#pragma unroll
            for (int m = 0; m < 4; ++m)
#pragma unroll
                for (int n = 0; n < 2; ++n) acc[a][b][m][n] = (f32x4){0.f, 0.f, 0.f, 0.f};
    bf16x8 At[4][2], B0[2][2], B1[2][2];
    const char* cA = (const char*)g.A + (size_t)cur.pm * tstepA; const char* cB = (const char*)g.Bt + (size_t)cur.pn * tstepB;
    S.a_ready(cur);
    PG8_STAGE(PG8_SB(0, 0), cB, voffB); PG8_STAGE(PG8_SB(0, 1), cB + hstepB, voffB); PG8_STAGE(PG8_SA(0, 0), cA, voffA); PG8_STAGE(PG8_SA(0, 1), cA + hstepA, voffA);
    if (wr == 1) PG8_BAR;
    PG8_WAIT_V(2); PG8_BAR;
    PG8_STAGE(PG8_SB(1, 0), cB + kstep, voffB); PG8_STAGE(PG8_SA(1, 0), cA + kstep, voffA); PG8_STAGE(PG8_SB(1, 1), cB + hstepB + kstep, voffB);
    PG8_WAIT_V(6); PG8_BAR;
    for (;;) {
        const bool has_next = S.next(ui + 1, nxt);
        const char* nA = has_next ? (const char*)g.A + (size_t)nxt.pm * tstepA : cA; const char* nB = has_next ? (const char*)g.Bt + (size_t)nxt.pn * tstepB : cB;
        for (int t = 0; t < nt; t += 2) {
            const bool last = (t == nt - 2);
            const char* a1 = cA + (size_t)(t + 1) * kstep;
            const char* a2 = last ? nA : cA + (size_t)(t + 2) * kstep; const char* b2 = last ? nB : cB + (size_t)(t + 2) * kstep;
            const char* a3 = a2 + kstep; const char* b3 = b2 + kstep;
            if (last && has_next) S.a_ready(nxt);
            PG8_LDB(B0, 0, 0); PG8_LDB(B1, 0, 1); PG8_SCHED; PG8_LDA(At, 0, 0); PG8_STAGE(PG8_SA(1, 1), a1 + hstepA, voffA);
            PG8_WAIT_V(8); PG8_WAIT_L(0); PG8_BAR; PG8_MMA(0, 0, At, B0); PG8_MMA(0, 1, At, B1); PG8_BAR; PG8_SCHED;
            PG8_LDA(At, 0, 1); PG8_STAGE(PG8_SB(0, 0), b2, voffB); PG8_STAGE(PG8_SB(0, 1), b2 + hstepB, voffB); PG8_STAGE(PG8_SA(0, 0), a2, voffA);
            PG8_WAIT_V(8); PG8_WAIT_L(0); PG8_BAR; PG8_MMA(1, 0, At, B0); PG8_MMA(1, 1, At, B1); PG8_BAR; PG8_SCHED;
            PG8_LDB(B0, 1, 0); PG8_LDB(B1, 1, 1); PG8_SCHED; PG8_LDA(At, 1, 0); PG8_STAGE(PG8_SA(0, 1), a2 + hstepA, voffA);
            PG8_WAIT_V(8); PG8_WAIT_L(0); PG8_BAR; PG8_MMA(0, 0, At, B0); PG8_MMA(0, 1, At, B1); PG8_BAR; PG8_SCHED;
            PG8_LDA(At, 1, 1); PG8_STAGE(PG8_SB(1, 0), b3, voffB); PG8_STAGE(PG8_SB(1, 1), b3 + hstepB, voffB); PG8_STAGE(PG8_SA(1, 0), a3, voffA);
            PG8_WAIT_V(8); PG8_WAIT_L(0); PG8_BAR; PG8_MMA(1, 0, At, B0); PG8_MMA(1, 1, At, B1); PG8_BAR; PG8_SCHED;
        }
        if constexpr (ALIGN_EPI) { if (wr == 0) PG8_BAR; }
        if constexpr (!Epi::AFTER_DRAIN) { E(acc, cur, wr, wc, fr, fq); S.done(cur); }
        if (!has_next) break;
#pragma unroll
        for (int a = 0; a < 2; ++a)
#pragma unroll
            for (int b = 0; b < 2; ++b)
#pragma unroll
                for (int m = 0; m < 4; ++m)
#pragma unroll
                    for (int n = 0; n < 2; ++n) acc[a][b][m][n] = (f32x4){0.f, 0.f, 0.f, 0.f};
        cur = nxt; cA = nA; cB = nB; ++ui;
        if constexpr (ALIGN_EPI) { if (wr == 1) PG8_BAR; }
    }
    PG8_WAIT_V(0);
    if constexpr (!ALIGN_EPI) { if (wr == 0) PG8_BAR; }
    PG8_BAR;
    if constexpr (Epi::AFTER_DRAIN) { E.fused(acc, cur, wr, wc, fr, fq, lds, wid, lane); S.done(cur); }
#undef PG8_SA
#undef PG8_SB
#undef PG8_STAGE
#undef PG8_LDA
#undef PG8_LDB
#undef PG8_MMA
#undef PG8_WAIT_V
#undef PG8_WAIT_L
#undef PG8_BAR
#undef PG8_SCHED
}
}


__device__ __forceinline__ int map_col(int kind, int n) {
    if (kind == 1) { if (n < 704) return n; if (n < 720) return 2752 + (n - 704); if (n < 768) return -1; return 704 + (n - 768); }
    if (kind == 2) { const int hd = n / 192, j = n % 192; if (j < 128) return n; const int i2 = j - 128; return hd * 192 + 128 + (i2 >> 1) + 32 * (i2 & 1); }
    return n;
}
__device__ __forceinline__ void transpose_item(const float* W, int K, int Nsrc, int Ndst, bf16_t* WT, const float* kscale, int kind, LAS float* scr, int item, int lane) {
    const int nblk = Ndst / 32, kb = item / nblk, nb = item % nblk, k0 = 64 * kb, n0 = 32 * nb;
    const int sc_ = map_col(kind, n0 + (lane & 31));
#pragma unroll 8
    for (int i = 0; i < 32; ++i) { const int kk = 2 * i + (lane >> 5); float v = 0.f;
        if (sc_ >= 0) { v = W[(size_t)(k0 + kk) * Nsrc + sc_]; if (kscale) v *= kscale[k0 + kk]; }
        scr[kk * 33 + (lane & 31)] = v; }
    asm volatile("s_waitcnt lgkmcnt(0)" ::: "memory");
    const int c = lane & 7;
#pragma unroll
    for (int j = 0; j < 4; ++j) { const int n = (lane >> 3) + 8 * j; const LAS float* s = scr + (8 * c) * 33 + n;
        u32x4 o; o.x = cvt_pk(s[0 * 33], s[1 * 33]); o.y = cvt_pk(s[2 * 33], s[3 * 33]); o.z = cvt_pk(s[4 * 33], s[5 * 33]); o.w = cvt_pk(s[6 * 33], s[7 * 33]);
        *(u32x4*)(WT + (size_t)(n0 + n) * K + k0 + 8 * c) = o; }
    asm volatile("s_waitcnt lgkmcnt(0)" ::: "memory");
}

template <bool OUT_BF16> __device__ __forceinline__ void norm_mod_row2(const float* xrow0, const float* xrow1, const float* g, const float* scale0, const float* shift0, const float* scale1, const float* shift1,
                                                                       void* orow0, void* orow1, int lane) {
    const f32x4* xr0 = (const f32x4*)xrow0 + lane; const f32x4* xr1 = (const f32x4*)xrow1 + lane;
    f32x4 v0[4], v1[4]; float s0 = 0.f, s1 = 0.f;
#pragma unroll
    for (int j = 0; j < 4; ++j) { v0[j] = xr0[64 * j]; v1[j] = xr1[64 * j]; }
#pragma unroll
    for (int j = 0; j < 4; ++j) { s0 += (v0[j].x * v0[j].x + v0[j].y * v0[j].y) + (v0[j].z * v0[j].z + v0[j].w * v0[j].w); s1 += (v1[j].x * v1[j].x + v1[j].y * v1[j].y) + (v1[j].z * v1[j].z + v1[j].w * v1[j].w); }
    const float rstd0 = rsqrtf(wave_sum(s0) * (1.f / DM) + EPS), rstd1 = rsqrtf(wave_sum(s1) * (1.f / DM) + EPS);
#pragma unroll
    for (int j = 0; j < 4; ++j) { const int c = 4 * (64 * j + lane);
        const f32x4 gg = *(const f32x4*)(g + c);
        const f32x4 y0 = (v0[j] * rstd0) * gg * (*(const f32x4*)(scale0 + c) + 1.f) + *(const f32x4*)(shift0 + c);
        const f32x4 y1 = (v1[j] * rstd1) * gg * (*(const f32x4*)(scale1 + c) + 1.f) + *(const f32x4*)(shift1 + c);
        if (OUT_BF16) { u32x2 w; w.x = cvt_pk(y0.x, y0.y); w.y = cvt_pk(y0.z, y0.w); *((u32x2*)orow0 + 64 * j + lane) = w; w.x = cvt_pk(y1.x, y1.y); w.y = cvt_pk(y1.z, y1.w); *((u32x2*)orow1 + 64 * j + lane) = w; }
        else { *((f32x4*)orow0 + 64 * j + lane) = y0; *((f32x4*)orow1 + 64 * j + lane) = y1; } }
}

template <bool OUT_BF16, int NR> __device__ __forceinline__ void norm_rows_b(int m0, int stride, const bf16_t* xin, const float* g, const float* modb, int mstride, int soff, int hoff, bf16_t* ob, float* of, int lane) {
    int mr[NR]; u32x4 v[NR][2]; float rstd[NR];
#pragma unroll
    for (int k = 0; k < NR; ++k) { const int m = m0 + k * stride; mr[k] = m < M_TOK ? m : m0;
#pragma unroll
        for (int j = 0; j < 2; ++j) v[k][j] = *(const u32x4*)(xin + (size_t)mr[k] * DM + 512 * j + lane * 8); }
#pragma unroll
    for (int k = 0; k < NR; ++k) { float s = 0.f;
#pragma unroll
        for (int j = 0; j < 2; ++j) { const u32x4 w = v[k][j]; const float x0 = bf_lo(w.x), x1 = bf_hi(w.x), x2 = bf_lo(w.y), x3 = bf_hi(w.y), x4 = bf_lo(w.z), x5 = bf_hi(w.z), x6 = bf_lo(w.w), x7 = bf_hi(w.w);
            s += (x0 * x0 + x1 * x1) + (x2 * x2 + x3 * x3) + (x4 * x4 + x5 * x5) + (x6 * x6 + x7 * x7); }
        rstd[k] = rsqrtf(wave_sum(s) * (1.f / DM) + EPS); }
#pragma unroll
    for (int j = 0; j < 2; ++j) { const int c = 512 * j + lane * 8; const f32x4 g0 = *(const f32x4*)(g + c), g1 = *(const f32x4*)(g + c + 4);
#pragma unroll
        for (int k = 0; k < NR; ++k) { const float* md = modb + (size_t)seq_of_row(mr[k]) * mstride; const u32x4 w = v[k][j];
            const f32x4 xa = {bf_lo(w.x), bf_hi(w.x), bf_lo(w.y), bf_hi(w.y)}, xb = {bf_lo(w.z), bf_hi(w.z), bf_lo(w.w), bf_hi(w.w)};
            const f32x4 ya = (xa * rstd[k]) * g0 * (*(const f32x4*)(md + soff + c) + 1.f) + *(const f32x4*)(md + hoff + c);
            const f32x4 yb = (xb * rstd[k]) * g1 * (*(const f32x4*)(md + soff + c + 4) + 1.f) + *(const f32x4*)(md + hoff + c + 4);
            if (OUT_BF16) *(u32x4*)(ob + (size_t)mr[k] * DM + c) = (u32x4){cvt_pk(ya.x, ya.y), cvt_pk(ya.z, ya.w), cvt_pk(yb.x, yb.y), cvt_pk(yb.z, yb.w)};
            else { *(f32x4*)(of + (size_t)mr[k] * DM + c) = ya; *(f32x4*)(of + (size_t)mr[k] * DM + c + 4) = yb; } } }
}

namespace att {
using f32x16 = __attribute__((ext_vector_type(16))) float;
using s16x4 = __attribute__((ext_vector_type(4))) short;
constexpr int NW = 8, QBLK = 32, KVBLK = 64, DQK = 192, DV = 128;
constexpr int LDQ = 768, LDKV = 1024, LDR = 768, LDO = 1024;
constexpr float THRL = 11.5f;
constexpr int NSLOT = 3;
constexpr size_t SHM_V = KVBLK * DV * 2, SHM_K = KVBLK * DQK * 2, SHM_QS = NSLOT * SHM_V + NSLOT * SHM_K + NW * 64 * 4, SHM_ATTN = SHM_QS + NW * 4096;
#define KSWZ(row, colB) ((row) * 384 + ((colB) ^ ((((row) >> 1) & 7) << 4)))
#define SBAR() __builtin_amdgcn_sched_barrier(0)
__device__ __forceinline__ int crow(int r, int hi) { return (r & 3) + 8 * (r >> 2) + 4 * hi; }
__device__ __forceinline__ void partialSM(f32x16& p0, f32x16& p1, float& m_reg, float& mn, float& alpha) {
    float pmax = p0[0];
#pragma unroll
    for (int r = 1; r < 16; ++r) pmax = fmaxf(pmax, p0[r]);
#pragma unroll
    for (int r = 0; r < 16; ++r) pmax = fmaxf(pmax, p1[r]);
    { auto rr = __builtin_amdgcn_permlane32_swap(__float_as_uint(pmax), __float_as_uint(pmax), false, false);
      pmax = fmaxf(__uint_as_float(rr[0]), __uint_as_float(rr[1])); }
    if (__builtin_expect(__all(pmax - m_reg <= THRL), 1)) { mn = m_reg; alpha = 1.f; }
    else { mn = fmaxf(m_reg, pmax); alpha = __builtin_amdgcn_exp2f(m_reg - mn); m_reg = mn; }
#pragma unroll
    for (int r = 0; r < 16; ++r) p0[r] = p0[r] - mn;
#pragma unroll
    for (int r = 0; r < 16; ++r) p1[r] = p1[r] - mn;
#pragma unroll
    for (int r = 0; r < 16; ++r) p0[r] = __builtin_amdgcn_exp2f(p0[r]);
}
__device__ __forceinline__ void finishSM(f32x16& p0, f32x16& p1, float alpha, float& l_reg, bf16x8& pa0, bf16x8& pa1, bf16x8& pa2, bf16x8& pa3) {
#pragma unroll
    for (int r = 0; r < 16; ++r) p1[r] = __builtin_amdgcn_exp2f(p1[r]);
    float ps = 0;
#pragma unroll
    for (int r = 0; r < 16; ++r) ps += p0[r];
#pragma unroll
    for (int r = 0; r < 16; ++r) ps += p1[r];
    { auto rr = __builtin_amdgcn_permlane32_swap(__float_as_uint(ps), __float_as_uint(ps), false, false);
      ps = __uint_as_float(rr[0]) + __uint_as_float(rr[1]); }
    l_reg = l_reg * alpha + ps;
#define PK4(P, BASE, OUT) do { unsigned a0 = cvt_pk(P[BASE + 0], P[BASE + 1]), a1 = cvt_pk(P[BASE + 2], P[BASE + 3]);   \
    unsigned b0 = cvt_pk(P[BASE + 4], P[BASE + 5]), b1 = cvt_pk(P[BASE + 6], P[BASE + 7]);                              \
    auto r0 = __builtin_amdgcn_permlane32_swap(a0, b0, false, false); auto r1 = __builtin_amdgcn_permlane32_swap(a1, b1, false, false); \
    u32x4 w = {r0[0], r1[0], r0[1], r1[1]}; OUT = *reinterpret_cast<bf16x8*>(&w); } while (0)
    PK4(p0, 0, pa0); PK4(p0, 8, pa1); PK4(p1, 0, pa2); PK4(p1, 8, pa3);
#undef PK4
}
__device__ __forceinline__ void qkt(f32x16& p0, f32x16& p1, const char* Ks, const bf16x8* qr, const char* Qs, int r32, int hi) {
    p0 = f32x16{}; p1 = f32x16{};
#pragma unroll
    for (int d0 = 0; d0 < 12; ++d0) { const int cb = (d0 * 16 + hi * 8) * 2;
        const bf16x8 qf = qr[d0];
        const bf16x8 b0 = *reinterpret_cast<const bf16x8*>(Ks + KSWZ(r32, cb));
        const bf16x8 b1 = *reinterpret_cast<const bf16x8*>(Ks + KSWZ(32 + r32, cb));
        p0 = __builtin_amdgcn_mfma_f32_32x32x16_bf16(b0, qf, p0, 0, 0, 0);
        p1 = __builtin_amdgcn_mfma_f32_32x32x16_bf16(b1, qf, p1, 0, 0, 0); }
}
__device__ __forceinline__ int v_st(int k, int c) { const int kk = (k & ~0xC) | ((k & 4) << 1) | ((k & 8) >> 1); return ((kk >> 3) * 4 + (c >> 5)) * 512 + ((kk & 7) * 32 + (c & 31)) * 2; }
__device__ __forceinline__ int v_rd_base(int lane) { return ((lane & 3) << 3) | (((lane >> 2) & 3) << 6) | (((lane >> 4) & 1) << 5) | (((lane >> 5) & 1) << 8); }
constexpr int v_rd_off(int d0, int ks, int half) { return d0 * 512 + ks * 4096 + half * 2048; }
template <int OFF> __device__ __forceinline__ s16x4 tr_read(int vb) {
    s16x4 r; asm volatile("ds_read_b64_tr_b16 %0, %1 offset:%2" : "=&v"(r) : "v"(vb), "i"(OFF) : "memory"); return r;
}
template <int D0> __device__ __forceinline__ void pv_one(f32x16& od, int vb, bf16x8 pa0, bf16x8 pa1, bf16x8 pa2, bf16x8 pa3) {
    const s16x4 l0 = tr_read<v_rd_off(D0, 0, 0)>(vb), h0 = tr_read<v_rd_off(D0, 0, 1)>(vb), l1 = tr_read<v_rd_off(D0, 1, 0)>(vb), h1 = tr_read<v_rd_off(D0, 1, 1)>(vb);
    const s16x4 l2 = tr_read<v_rd_off(D0, 2, 0)>(vb), h2 = tr_read<v_rd_off(D0, 2, 1)>(vb), l3 = tr_read<v_rd_off(D0, 3, 0)>(vb), h3 = tr_read<v_rd_off(D0, 3, 1)>(vb);
    asm volatile("s_waitcnt lgkmcnt(0)" ::: "memory"); SBAR();
#define PK(L, H) (bf16x8){L[0], L[1], L[2], L[3], H[0], H[1], H[2], H[3]}
    od = __builtin_amdgcn_mfma_f32_32x32x16_bf16(pa0, PK(l0, h0), od, 0, 0, 0);
    od = __builtin_amdgcn_mfma_f32_32x32x16_bf16(pa1, PK(l1, h1), od, 0, 0, 0);
    od = __builtin_amdgcn_mfma_f32_32x32x16_bf16(pa2, PK(l2, h2), od, 0, 0, 0);
    od = __builtin_amdgcn_mfma_f32_32x32x16_bf16(pa3, PK(l3, h3), od, 0, 0, 0);
#undef PK
}
__device__ __forceinline__ void pv_d0(f32x16* o, int vb, bf16x8 pa0, bf16x8 pa1, bf16x8 pa2, bf16x8 pa3) {
    pv_one<0>(o[0], vb, pa0, pa1, pa2, pa3); pv_one<1>(o[1], vb, pa0, pa1, pa2, pa3); pv_one<2>(o[2], vb, pa0, pa1, pa2, pa3); pv_one<3>(o[3], vb, pa0, pa1, pa2, pa3);
}
__device__ __forceinline__ void attn_unit(const bf16_t* __restrict__ Qb, const bf16_t* __restrict__ Kn, const bf16_t* __restrict__ Vh, const bf16_t* __restrict__ Kr,
                                          bf16_t* __restrict__ Ob, int seq, int pos0, char* lds) {
    int tid_ = threadIdx.x; asm volatile("" : "+v"(tid_));
    const int tid = tid_, wid = tid >> 6, lane = tid & 63, r32 = lane & 31, hi = lane >> 5;
    char* V_lds = lds; char* K_lds = lds + NSLOT * SHM_V; char* Qs = lds + SHM_QS + wid * 4096 + lane * 16;
    float* ws = (float*)(lds + NSLOT * SHM_V + NSLOT * SHM_K) + wid * 64; float* li_l = ws; float* al_l = ws + 32;
    float m_reg = -1e30f, l_reg = 0; f32x16 o[4] = {}; bf16x8 qr[12];
    const bf16_t* Qw = Qb + (long)(wid * QBLK + r32) * LDQ + hi * 8;
#pragma unroll
    for (int d0 = 0; d0 < 8; ++d0) qr[d0] = *reinterpret_cast<const bf16x8*>(Qw + d0 * 16);
#pragma unroll
    for (int d0 = 8; d0 < 12; ++d0) {
        const u32x4 qv = *reinterpret_cast<const u32x4*>(Qw + d0 * 16); const double pos = (double)(pos0 + wid * QBLK + r32); unsigned w[4] = {qv.x, qv.y, qv.z, qv.w};
#pragma unroll
        for (int t = 0; t < 4; ++t) { const double rev = pos * c_invrev[(d0 - 8) * 8 + hi * 4 + t]; const float fr_ = (float)(rev - rint(rev));
            const float sn = __builtin_amdgcn_sinf(fr_), cs = __builtin_amdgcn_cosf(fr_); const float x1 = bf_lo(w[t]), x2 = bf_hi(w[t]);
            w[t] = cvt_pk(x1 * cs - x2 * sn, x2 * cs + x1 * sn); }
        const u32x4 wq = {w[0], w[1], w[2], w[3]}; qr[d0] = __builtin_bit_cast(bf16x8, wq); }
    const int vb0 = (int)(uintptr_t)V_lds + v_rd_base(lane);
    const bf16_t* dk_[3]; int dks_[3]; const bf16_t* dv_[2];
#pragma unroll
    for (int i = 0; i < 3; ++i) { const int p = (wid * 3 + i) * 64 + lane, row = p / 24, cq = p % 24, c = (cq & ~7) | ((cq & 7) ^ ((row >> 1) & 7));
        dk_[i] = c < 16 ? Kn + (long)row * LDKV + c * 8 : Kr + (long)row * LDR + (c - 16) * 8; dks_[i] = c < 16 ? LDKV : LDR; }
#pragma unroll
    for (int i = 0; i < 2; ++i) { const int p = (wid * 2 + i) * 64 + lane, sub = p >> 5, within = p & 31, kk = (sub >> 2) * 8 + (within >> 2), c = (sub & 3) * 32 + (within & 3) * 8;
        const int k = (kk & ~0xC) | ((kk & 4) << 1) | ((kk & 8) >> 1); dv_[i] = Vh + (long)k * LDKV + c; }
    const unsigned ldsK0 = (unsigned)(uintptr_t)K_lds + (unsigned)__builtin_amdgcn_readfirstlane(wid) * 3072u, ldsV0 = (unsigned)(uintptr_t)V_lds + (unsigned)__builtin_amdgcn_readfirstlane(wid) * 2048u;
#define DMA_TILE(k0, slot) do { \
    _Pragma("unroll") for (int i_ = 0; i_ < 3; ++i_) __builtin_amdgcn_global_load_lds((const unsigned*)(dk_[i_] + (long)(k0) * dks_[i_]), (LAS unsigned*)(ldsK0 + (unsigned)(slot) * (unsigned)SHM_K + i_ * 1024u), 16, 0, 0); \
    _Pragma("unroll") for (int i_ = 0; i_ < 2; ++i_) __builtin_amdgcn_global_load_lds((const unsigned*)(dv_[i_] + (long)(k0) * LDKV), (LAS unsigned*)(ldsV0 + (unsigned)(slot) * (unsigned)SHM_V + i_ * 1024u), 16, 0, 0); } while (0)
#define SWAIT() asm volatile("s_waitcnt vmcnt(0)" ::: "memory")
#define RESC(a) do { if (__any((a) < 1.f)) { if (hi == 0) al_l[r32] = (a); asm volatile("s_waitcnt lgkmcnt(0)" ::: "memory"); \
    _Pragma("unroll") for (int d = 0; d < 4; ++d) _Pragma("unroll") for (int r = 0; r < 16; ++r) o[d][r] *= al_l[crow(r, hi)]; } } while (0)
    f32x16 pA0, pA1, pB0, pB1; float mnA, mnB, alA, alB; bf16x8 pa0, pa1, pa2, pa3; const int NT = seq / KVBLK;
    int s_prev = 0, s_cur = 1, s_next = 2;
    DMA_TILE(0, 0); DMA_TILE(KVBLK, 1); SWAIT(); __syncthreads();
    qkt(pA0, pA1, K_lds, qr, Qs, r32, hi); partialSM(pA0, pA1, m_reg, mnA, alA);
#define ROT3() do { const int t_ = s_prev; s_prev = s_cur; s_cur = s_next; s_next = t_; } while (0)
#define ASTEP(j, N0, N1, MN_N, AL_N, O0, O1, AL_O) do { \
        SBAR(); DMA_TILE(((j) + 1) * KVBLK, s_next); SBAR();        \
        qkt(N0, N1, K_lds + s_cur * SHM_K, qr, Qs, r32, hi); \
        finishSM(O0, O1, AL_O, l_reg, pa0, pa1, pa2, pa3); SBAR(); \
        pv_d0(o, vb0 + s_prev * (int)SHM_V, pa0, pa1, pa2, pa3); partialSM(N0, N1, m_reg, MN_N, AL_N); \
        SWAIT(); \
        RESC(AL_N); __syncthreads(); ROT3(); } while (0)
    for (int j = 1; j + 1 < NT; j += 2) {
        ASTEP(j, pB0, pB1, mnB, alB, pA0, pA1, alA);
        ASTEP(j + 1, pA0, pA1, mnA, alA, pB0, pB1, alB);
    }
    SBAR(); qkt(pB0, pB1, K_lds + s_cur * SHM_K, qr, Qs, r32, hi);
    finishSM(pA0, pA1, alA, l_reg, pa0, pa1, pa2, pa3); SBAR();
    pv_d0(o, vb0 + s_prev * (int)SHM_V, pa0, pa1, pa2, pa3); partialSM(pB0, pB1, m_reg, mnB, alB);
    RESC(alB);
    finishSM(pB0, pB1, alB, l_reg, pa0, pa1, pa2, pa3); SBAR();
    pv_d0(o, vb0 + s_cur * (int)SHM_V, pa0, pa1, pa2, pa3);
#undef ASTEP
#undef ROT3
    if (hi == 0) li_l[r32] = l_reg; asm volatile("s_waitcnt lgkmcnt(0)" ::: "memory");
    float rli[16];
#pragma unroll
    for (int r = 0; r < 16; ++r) rli[r] = __builtin_amdgcn_rcpf(li_l[crow(r, hi)]);
    bf16_t* Ow = Ob + (long)(wid * QBLK) * LDO;
#pragma unroll
    for (int r = 0; r < 16; ++r) { const int orow = crow(r, hi);
#pragma unroll
        for (int d0 = 0; d0 < 4; ++d0) Ow[(long)orow * LDO + d0 * 32 + r32] = f2bf(o[d0][r] * rli[r]); }
    __syncthreads();
#undef DMA_TILE
#undef SWAIT
#undef RESC
}
#undef KSWZ
#undef SBAR
}

__device__ __forceinline__ f32x4 mfma16(bf16x8 a, bf16x8 b, f32x4 c) { return __builtin_amdgcn_mfma_f32_16x16x32_bf16(a, b, c, 0, 0, 0); }
constexpr int PL_QN = 0, PL_KN = 17408, PL_KK = 34816, PL_QK = 51456, PL_A0 = 68096, PL_GC = 100864, PL_BT = 101376;
__device__ __forceinline__ void gdn_prep_item(int cgi, int h, LAS unsigned char* lds, const bf16_t* bufQKV, const float* convw, const bf16_t* bufA, const float* alf, const float* alb, const float* dtf, const float* dtb,
                                              bf16_t* GQ, bf16_t* GK, bf16_t* GV, bf16_t* KT, bf16_t* TINV, bf16_t* ATT, float* gcum) {
    int tid_ = threadIdx.x; asm volatile("" : "+v"(tid_));
    const int tid = tid_, wave = __builtin_amdgcn_readfirstlane(tid >> 6), lane = tid & 63;
    const int r0 = cgi * 64, sq = seq_of_row(r0), slo = seq_start(sq), shi = slo + seq_len(sq);
    if (tid < 384) {
        const int p = tid % 48, rg = tid / 48, sec = p >> 4, w = p & 15, col = sec * 512 + h * 128 + w * 8;
        f32x4 cw[5][2];
#pragma unroll
        for (int tap = 0; tap < 5; ++tap) { cw[tap][0] = *(const f32x4*)(convw + tap * 1536 + col); cw[tap][1] = *(const f32x4*)(convw + tap * 1536 + col + 4); }
        u32x4 xin[12];
#pragma unroll
        for (int q = 0; q < 12; ++q) { const int rr = r0 + rg * 8 + q - 2; xin[q] = (u32x4){0u, 0u, 0u, 0u};
            if (rr >= slo && rr < shi) xin[q] = *(const u32x4*)(bufQKV + ((size_t)(sec * 4 + h) * M_TOK + rr) * 128 + w * 8); }
        const int gld = sec < 2 ? 128 : 32;
        bf16_t* gbase = sec < 2 ? (sec == 0 ? GQ : GK) + ((size_t)h * M_TOK + r0 + rg * 8) * 128 + w * 8 : GV + ((size_t)(h * 4 + (w >> 2)) * M_TOK + r0 + rg * 8) * 32 + (w & 3) * 8;
#pragma unroll
        for (int rr = 0; rr < 8; ++rr) {
            float a[8] = {0.f, 0.f, 0.f, 0.f, 0.f, 0.f, 0.f, 0.f};
#pragma unroll
            for (int tap = 0; tap < 5; ++tap) { const u32x4 xv = xin[rr + tap]; const f32x4 c0 = cw[tap][0], c1 = cw[tap][1];
                a[0] += bf_lo(xv.x) * c0[0]; a[1] += bf_hi(xv.x) * c0[1]; a[2] += bf_lo(xv.y) * c0[2]; a[3] += bf_hi(xv.y) * c0[3];
                a[4] += bf_lo(xv.z) * c1[0]; a[5] += bf_hi(xv.z) * c1[1]; a[6] += bf_lo(xv.w) * c1[2]; a[7] += bf_hi(xv.w) * c1[3]; }
            float ss = 0.f;
#pragma unroll
            for (int e = 0; e < 8; ++e) { a[e] = siluf(a[e]); ss += a[e] * a[e]; }
            ss = row16_sum(ss);
            const float sc = sec < 2 ? rsqrtf(ss + EPS) : 1.f;
            u32x4 w8; w8.x = cvt_pk(a[0] * sc, a[1] * sc); w8.y = cvt_pk(a[2] * sc, a[3] * sc); w8.z = cvt_pk(a[4] * sc, a[5] * sc); w8.w = cvt_pk(a[6] * sc, a[7] * sc);
            *(u32x4*)(gbase + (size_t)rr * gld) = w8;
            if (sec < 2) *(LAS u32x4*)(lds + (sec ? PL_KN : PL_QN) + ((rg * 8 + rr) * 136 + w * 8) * 2) = w8;
        }
    }
    __syncthreads();
    { const int l15 = lane & 15, l4 = lane >> 4;
#pragma unroll
      for (int tt = 0; tt < 4; ++tt) { const int t = wave * 4 + tt, mat = t >> 4, ti = (t >> 2) & 3, tj = t & 3; f32x4 acc = {0.f, 0.f, 0.f, 0.f};
#pragma unroll
          for (int ks = 0; ks < 4; ++ks) { const bf16x8 av = *(const LAS bf16x8*)(lds + (mat ? PL_QN : PL_KN) + ((16 * ti + l15) * 136 + 32 * ks + 8 * l4) * 2);
              const bf16x8 bv = *(const LAS bf16x8*)(lds + PL_KN + ((16 * tj + l15) * 136 + 32 * ks + 8 * l4) * 2); acc = mfma16(av, bv, acc); }
          LAS float* dst = (LAS float*)(lds + (mat ? PL_QK : PL_KK));
#pragma unroll
          for (int r = 0; r < 4; ++r) dst[(16 * ti + 4 * l4 + r) * 65 + 16 * tj + l15] = acc[r]; } }
    LAS float* GC = (LAS float*)(lds + PL_GC); LAS float* BT = (LAS float*)(lds + PL_BT);
    if (wave < 2) { const int d = wave, row = r0 + (d ? 63 - lane : lane);
        float gc, b; gate_vals(bufA, row, d, h, alf, alb, dtf, dtb, gc, b);
#pragma unroll
        for (int off = 1; off < 64; off <<= 1) { const float t = __shfl_up(gc, off); if (lane >= off) gc += t; }
        GC[d * 64 + lane] = gc; BT[d * 64 + lane] = b; gcum[(size_t)row * 16 + d * 4 + h] = gc; }
    __syncthreads();
    { const LAS float* KK = (const LAS float*)(lds + PL_KK); const LAS float* QK = (const LAS float*)(lds + PL_QK); LAS float* Ad = (LAS float*)(lds + PL_A0);
#pragma unroll 2
      for (int it = 0; it < 8; ++it) { const int e2 = tid + 512 * it, d = e2 >> 11, i = (e2 >> 5) & 63, j0 = (e2 & 31) * 2, ri = d ? 63 - i : i;
          const float gi = GC[d * 64 + i], bi = BT[d * 64 + i]; float at[2];
#pragma unroll
          for (int q = 0; q < 2; ++q) { const int j = j0 + q, rj = d ? 63 - j : j; const float dec = __expf(fminf(gi - GC[d * 64 + j], 0.f));
              Ad[d * 4096 + i * 64 + (j & 3) * 16 + (j >> 2)] = (j < i) ? KK[ri * 65 + rj] * bi * dec : 0.f;
              at[q] = (j <= i) ? QK[ri * 65 + rj] * dec * DKS : 0.f; }
          *(unsigned*)(ATT + ((size_t)((cgi * 4 + h) * 2 + d) * 64 + i) * 64 + j0) = cvt_pk(at[0], at[1]); } }
    __syncthreads();
    { const int idx = wave * 16 + (lane >> 2), d = idx >> 6, c = idx & 63, ph = lane & 3;
      const LAS float* A = (const LAS float*)(lds + PL_A0) + d * 4096 + ph * 16; float Xq[16];
#pragma unroll
      for (int q = 0; q < 16; ++q) Xq[q] = 0.f;
      bf16_t* T = TINV + (size_t)((cgi * 4 + h) * 2 + d) * 4096 + c;
#pragma unroll
      for (int i = 0; i < 64; ++i) { float part = 0.f;
#pragma unroll
          for (int jj = 0; jj < (i + 3) / 4; ++jj) part += A[i * 64 + jj] * Xq[jj];
          part += __int_as_float(__builtin_amdgcn_update_dpp(0, __float_as_int(part), 0xB1, 0xF, 0xF, false));
          part += __int_as_float(__builtin_amdgcn_update_dpp(0, __float_as_int(part), 0x4E, 0xF, 0xF, false));
          const float xi = ((i == c) ? 1.f : 0.f) - part;
          if (ph == (i & 3)) { Xq[i >> 2] = xi; T[i * 64] = f2bf(xi); } } }
    __syncthreads();
}

constexpr int SB_SZ = 58368, SB_QC = 17408, SB_TI = 34816, SB_AT = 44032, SB_VC = 53248;
constexpr int SL_ST = 116736, SL_RH = 125440, SL_VN = 130048, SL_VS = 134656, SL_SC = 139264, SL_SC_SZ = 1280;
#define SCAN_BAR() do { asm volatile("s_waitcnt lgkmcnt(0)" ::: "memory"); __builtin_amdgcn_s_barrier(); asm volatile("" ::: "memory"); } while (0)
template <int DVS>
__device__ __forceinline__ void gdn_scan_chain(int shd, int dvs, LAS unsigned char* lds, const float* gates, const bf16_t* GQ, const bf16_t* GK, const bf16_t* GV,
                                               const bf16_t* TINV, const bf16_t* ATT, bf16_t* OD) {
    constexpr int VP = DVS / 8 + 1, VLD = DVS + 8;
    constexpr int NPIECE = 3328 + 64 * VP, NDMA = (NPIECE + 63) / 64;
    constexpr int NDT = DVS / 16;
    int tid_ = threadIdx.x; asm volatile("" : "+v"(tid_));
    const int tid = tid_, wave = __builtin_amdgcn_readfirstlane(tid >> 6), lane = tid & 63, l15 = lane & 15, l4 = lane >> 4;
    const int sq = shd >> 3, h = (shd >> 1) & 3, d = shd & 1;
    const int N = seq_len(sq) / 64, c0g = seq_start(sq) / 64;
    const bool act = wave < 4 * NDT; const int tm = act ? wave >> 2 : 0, tn = wave & 3;
    const int sdv = NDT == 2 ? wave >> 2 : 0, sdk0 = NDT == 2 ? (wave & 3) * 2 : wave;
    const int v_slab = DVS == 32 ? dvs : dvs >> 1, v_col = DVS == 32 ? 0 : (dvs & 1) * 16;
    const bf16_t* src0[8]; int sstep[8];
#pragma unroll
    for (int t = 0; t < 8; ++t) { const int q = wave + 8 * t, P = q * 64 + lane; const bf16_t* b = GK; int st = 0;
        if (P < 2176) { const int pp = P < 1088 ? P : P - 1088, ip = pp / 17, pc = pp % 17, rm = d ? 63 - ip : ip; b = (P < 1088 ? GK : GQ) + ((size_t)h * M_TOK + rm) * 128 + (pc < 16 ? pc : 0) * 8; st = 64 * 128; }
        else if (P < 3328) { const int pp = P < 2752 ? P - 2176 : P - 2752, ip = pp / 9, pc = pp % 9; b = (P < 2752 ? TINV : ATT) + ((size_t)(h * 2 + d) * 64 + ip) * 64 + (pc < 8 ? pc : 0) * 8; st = 32768; }
        else if (P < NPIECE) { const int pp = P - 3328, ip = pp / VP, pc = pp % VP, rm = d ? 63 - ip : ip; b = GV + ((size_t)(h * 4 + v_slab) * M_TOK + rm) * 32 + v_col + (pc < VP - 1 ? pc : 0) * 8; st = 64 * 32; }
        src0[t] = b; sstep[t] = st; }
    const unsigned ldsb = (unsigned)(uintptr_t)lds;
    float pg = 0.f, pb = 0.f;
#define SC_DMA(n, nb) do { const int cgi_ = c0g + (d ? N - 1 - (n) : (n)); \
    if (wave == 0) { const size_t go_ = (size_t)(cgi_ * 64 + (d ? 63 - lane : lane)) * 16 + d * 4 + h; pg = gates[go_]; pb = gates[go_ + 8]; } \
    _Pragma("unroll") for (int t_ = 0; t_ < 8; ++t_) if (wave + 8 * t_ < NDMA) \
        __builtin_amdgcn_global_load_lds((const unsigned*)(src0[t_] + (size_t)cgi_ * sstep[t_]), (LAS unsigned*)(ldsb + (unsigned)(nb) * SB_SZ + (unsigned)(wave + 8 * t_) * 1024u), 16, 0, 0); } while (0)
#define SC_SCAL(nb) do { if (wave == 0) { const float gc_ = pg;            \
        const float gl_ = __int_as_float(__builtin_amdgcn_readlane(__float_as_int(gc_), 63)); LAS float* S_ = (LAS float*)(lds + SL_SC + (nb) * SL_SC_SZ); const float eg_ = __expf(gc_); \
        S_[lane] = pb * eg_; S_[64 + lane] = eg_ * DKS; S_[128 + lane] = __expf(gl_ - gc_); S_[192 + lane] = pb; if (lane == 0) S_[256] = __expf(gl_); } } while (0)
    for (int i = tid; i < 32 * 136 / 2; i += 512) ((LAS unsigned*)(lds + SL_ST))[i] = 0u;
    f32x4 Sx[NDT];
#pragma unroll
    for (int t = 0; t < NDT; ++t) Sx[t] = (f32x4){0.f, 0.f, 0.f, 0.f};
    SC_DMA(0, 0); SC_SCAL(0);
    asm volatile("s_waitcnt vmcnt(0)" ::: "memory"); SCAN_BAR();
    const int cp = 16 * tn + l15, dv0 = 16 * tm + 4 * l4;
#pragma unroll 1
    for (int n = 0; n < N; ++n) {
        const int cur = n & 1; const bool more = n + 1 < N;
        const LAS unsigned char* B = lds + cur * SB_SZ;
        if (more) SC_DMA(n + 1, cur ^ 1);
        const LAS float* SC = (const LAS float*)(lds + SL_SC + cur * SL_SC_SZ);
        f32x4 qs = {0.f, 0.f, 0.f, 0.f};
        if (act) {
            f32x4 aT = {0.f, 0.f, 0.f, 0.f}, aQ = {0.f, 0.f, 0.f, 0.f};
#pragma unroll
            for (int ks = 0; ks < 4; ++ks) { const bf16x8 a = *(const LAS bf16x8*)(lds + SL_ST + ((16 * tm + l15) * 136 + 32 * ks + 8 * l4) * 2);
                const bf16x8 bk = *(const LAS bf16x8*)(B + ((16 * tn + l15) * 136 + 32 * ks + 8 * l4) * 2);
                const bf16x8 bq = *(const LAS bf16x8*)(B + SB_QC + ((16 * tn + l15) * 136 + 32 * ks + 8 * l4) * 2);
                aT = mfma16(a, bk, aT); aQ = mfma16(a, bq, aQ); }
            const u32x2 vv = *(const LAS u32x2*)(B + SB_VC + (cp * VLD + dv0) * 2); const float bt = SC[192 + cp], s1 = SC[cp], s2 = SC[64 + cp];
            const float v0 = bf_lo(vv.x), v1 = bf_hi(vv.x), v2 = bf_lo(vv.y), v3 = bf_hi(vv.y);
            LAS bf16_t* RH = (LAS bf16_t*)(lds + SL_RH);
            RH[(dv0 + 0) * 72 + cp] = f2bf(v0 * bt - aT[0] * s1); RH[(dv0 + 1) * 72 + cp] = f2bf(v1 * bt - aT[1] * s1);
            RH[(dv0 + 2) * 72 + cp] = f2bf(v2 * bt - aT[2] * s1); RH[(dv0 + 3) * 72 + cp] = f2bf(v3 * bt - aT[3] * s1);
            qs = aQ * s2; }
        SCAN_BAR();
        if (act) {
            f32x4 acc = {0.f, 0.f, 0.f, 0.f};
#pragma unroll
            for (int ks = 0; ks < 2; ++ks) { const bf16x8 a = *(const LAS bf16x8*)(lds + SL_RH + ((16 * tm + l15) * 72 + 32 * ks + 8 * l4) * 2);
                const bf16x8 b = *(const LAS bf16x8*)(B + SB_TI + ((16 * tn + l15) * 72 + 32 * ks + 8 * l4) * 2); acc = mfma16(a, b, acc); }
            const float s3 = SC[128 + cp];
            LAS bf16_t* VN = (LAS bf16_t*)(lds + SL_VN); LAS bf16_t* VS = (LAS bf16_t*)(lds + SL_VS);
#pragma unroll
            for (int r = 0; r < 4; ++r) { VN[(dv0 + r) * 72 + cp] = f2bf(acc[r]); VS[(dv0 + r) * 72 + cp] = f2bf(acc[r] * s3); } }
        SCAN_BAR();
        if (more) SC_SCAL(cur ^ 1);
        if (act) {
            f32x4 acc = qs;
#pragma unroll
            for (int ks = 0; ks < 2; ++ks) { const bf16x8 a = *(const LAS bf16x8*)(lds + SL_VN + ((16 * tm + l15) * 72 + 32 * ks + 8 * l4) * 2);
                const bf16x8 b = *(const LAS bf16x8*)(B + SB_AT + ((16 * tn + l15) * 72 + 32 * ks + 8 * l4) * 2); acc = mfma16(a, b, acc); }
            const int cgi = c0g + (d ? N - 1 - n : n); const int row = cgi * 64 + (d ? 63 - cp : cp);
            u32x2 w; w.x = cvt_pk(acc[0], acc[1]); w.y = cvt_pk(acc[2], acc[3]);
            *(u32x2*)(OD + ((size_t)((d * 4 + h) * 4 + v_slab) * M_TOK + row) * 32 + v_col + dv0) = w; }
        {
          const float egl = SC[256];
#pragma unroll
          for (int t = 0; t < NDT; ++t) Sx[t] = Sx[t] * egl;
#pragma unroll
          for (int ks = 0; ks < 2; ++ks) { const bf16x8 a = *(const LAS bf16x8*)(lds + SL_VS + ((16 * sdv + l15) * 72 + 32 * ks + 8 * l4) * 2);
#pragma unroll
              for (int t = 0; t < NDT; ++t) {
                  const LAS bf16_t* kc0 = (const LAS bf16_t*)B + (32 * ks + 8 * l4) * 136 + 16 * (sdk0 + t) + l15;
                  u32x4 g0;
                  g0.x = (unsigned)kc0[0] | ((unsigned)kc0[136] << 16); g0.y = (unsigned)kc0[272] | ((unsigned)kc0[408] << 16); g0.z = (unsigned)kc0[544] | ((unsigned)kc0[680] << 16); g0.w = (unsigned)kc0[816] | ((unsigned)kc0[952] << 16);
                  Sx[t] = mfma16(a, __builtin_bit_cast(bf16x8, g0), Sx[t]); } }
          LAS bf16_t* ST = (LAS bf16_t*)(lds + SL_ST);
#pragma unroll
          for (int t = 0; t < NDT; ++t)
#pragma unroll
              for (int r = 0; r < 4; ++r) ST[(16 * sdv + 4 * l4 + r) * 136 + 16 * (sdk0 + t) + l15] = f2bf(Sx[t][r]); }
        asm volatile("s_waitcnt vmcnt(0)" ::: "memory"); SCAN_BAR();
    }
    SCAN_BAR();
#undef SC_DMA
#undef SC_SCAL
}


#define XB_TMO      128
#define XB_XCNT(j)  (256  + 64 * (j))
#define XB_XSUB(j)  (1280 + 64 * (j))
#define XB_XGEN(j)  (2304 + 64 * (j))
#define XB_TOP      3328
#define XB_TOPGEN   3392
#define XCD_BAR_WORDS 3456
#define XB_SPIN_CAP (1u << 18)

__device__ __forceinline__ unsigned xb_ld(unsigned* p)              { return __hip_atomic_load(p, __ATOMIC_RELAXED, __HIP_MEMORY_SCOPE_AGENT); }
__device__ __forceinline__ unsigned xb_add(unsigned* p, unsigned v) { return __hip_atomic_fetch_add(p, v, __ATOMIC_RELAXED, __HIP_MEMORY_SCOPE_AGENT); }
__device__ __forceinline__ unsigned xb_xcc_id() { return (unsigned)__builtin_amdgcn_s_getreg((3 << 11) | 20) & 0xFu; }
#define XB_SPIN(cond, bar) do { unsigned _sp = 0; while (cond) { __builtin_amdgcn_s_sleep(1); \
    if ((++_sp & 255u) == 0u) { if (xb_ld(&(bar)[XB_TMO])) break; if (_sp > XB_SPIN_CAP) { atomicAdd(&(bar)[XB_TMO], 1u); break; } } } } while (0)

struct XcdBarrier {
    unsigned* bar; unsigned x;
    volatile LAS unsigned* st;
};

__device__ __forceinline__ XcdBarrier xcd_barrier_post(unsigned* bar, volatile LAS unsigned* st) {
    XcdBarrier b; b.bar = bar; b.x = xb_xcc_id(); b.st = st;
    if (threadIdx.x == 0) (void)xb_add(&bar[XB_XCNT(b.x)], 1u);
    return b;
}
__device__ __forceinline__ void xcd_barrier_complete(unsigned* bar, unsigned x, unsigned& nloc, unsigned& nx) {
    const unsigned G = gridDim.x * gridDim.y * gridDim.z;
    unsigned sum, cnt, mine, sp = 0u;
    for (;;) {
        sum = 0u; cnt = 0u; mine = 0u;
#pragma unroll
        for (unsigned j = 0; j < 16; ++j) { const unsigned c = xb_ld(&bar[XB_XCNT(j)]); sum += c; cnt += (c > 0u) ? 1u : 0u; mine = (j == x) ? c : mine; }
        if (sum == G) break;
        __builtin_amdgcn_s_sleep(1);
        if ((++sp & 255u) == 0u) { if (xb_ld(&bar[XB_TMO])) break; if (sp > XB_SPIN_CAP) { atomicAdd(&bar[XB_TMO], 1u); break; } }
    }
    nloc = mine > 0u ? mine : 1u; nx = cnt > 0u ? cnt : 1u;
}

__device__ __forceinline__ void xcd_barrier(const XcdBarrier& b) {
    asm volatile("s_waitcnt vmcnt(0)" ::: "memory");
    __syncthreads();
    if (threadIdx.x == 0) {
        unsigned* bar = b.bar;
        __builtin_amdgcn_s_waitcnt(0);
        unsigned nloc = b.st[0], nx = b.st[1];
        if (nloc == 0u) { xcd_barrier_complete(bar, b.x, nloc, nx); b.st[0] = nloc; b.st[1] = nx; }
        const unsigned old = xb_add(&bar[XB_XSUB(b.x)], 1u);
        const unsigned gen = old / nloc;
        if (old + 1u == (gen + 1u) * nloc) {
            __builtin_amdgcn_fence(__ATOMIC_RELEASE, "agent");
            asm volatile("s_waitcnt vmcnt(0)" ::: "memory");
            const unsigned og = xb_add(&bar[XB_TOP], 1u);
            const unsigned tg = og / nx;
            if (og + 1u == (tg + 1u) * nx) xb_add(&bar[XB_TOPGEN], 1u);
            else XB_SPIN(xb_ld(&bar[XB_TOPGEN]) == tg, bar);
            __builtin_amdgcn_fence(__ATOMIC_ACQUIRE, "agent");
            xb_add(&bar[XB_XGEN(b.x)], 1u);
            asm volatile("s_waitcnt vmcnt(0)" ::: "memory");
        } else {
            XB_SPIN(xb_ld(&bar[XB_XGEN(b.x)]) == gen, bar);
            __builtin_amdgcn_fence(__ATOMIC_ACQUIRE, "agent");
            asm volatile("s_waitcnt vmcnt(0)" ::: "memory");
        }
    }
    __syncthreads();
}

constexpr int NPHASE = 14;
constexpr int LDS_BYTES = 163840, LDS_MISC = 157696;
struct Args { const float* in[25]; float* out; unsigned char* ws; int ph_lo, ph_hi; };

__global__ void __launch_bounds__(512, 2) fwd_kernel(Args a) {
    extern __shared__ __attribute__((aligned(16))) unsigned char lds_raw[];
    LAS unsigned char* lds = (LAS unsigned char*)lds_raw;
    cg::grid_group grid = cg::this_grid();
    const int tid = threadIdx.x, lane = tid & 63, wave = __builtin_amdgcn_readfirstlane(tid >> 6);
    const int G = gridDim.x, bid = blockIdx.x;
    const int gw = bid * 8 + wave, NGW = G * 8;
    unsigned char* ws = a.ws; unsigned char* dob = (unsigned char*)a.out;
    const float* xp = a.in[0]; const float* xs = a.in[1];
    bf16_t* Win_t = (bf16_t*)(ws + WS_WIN); bf16_t* Wuq_t = (bf16_t*)(ws + WS_WUQ); bf16_t* Wukv_t = (bf16_t*)(ws + WS_WUKV);
    bf16_t* Wout_t = (bf16_t*)(ws + WS_WOUT); bf16_t* W1_t = (bf16_t*)(ws + WS_W1); bf16_t* W2_t = (bf16_t*)(ws + WS_W2);
    float* mod = (float*)(ws + WS_MOD); float* modf_ = (float*)(ws + WS_MODF); float* rsq = (float*)(ws + WS_RSQ); float* rskv = (float*)(ws + WS_RSKV);
    float* gates = (float*)(ws + WS_GATES);
    bf16_t* R1 = (bf16_t*)(ws + WS_R1); bf16_t* TINV = (bf16_t*)(ws + WS_TINV); bf16_t* ATT = (bf16_t*)(ws + WS_ATT);
    bf16_t* bufQKV = (bf16_t*)(ws + WS_R2); bf16_t* OD = (bf16_t*)(ws + WS_R2); bf16_t* HID = (bf16_t*)dob;          bf16_t* X1 = (bf16_t*)(ws + WS_R2);
    bf16_t* bufZ = (bf16_t*)(ws + WS_Z); bf16_t* bufA = (bf16_t*)(ws + WS_A);
    bf16_t* GQ = (bf16_t*)(dob + DO_GQ); bf16_t* GK = (bf16_t*)(dob + DO_GK); bf16_t* GV = (bf16_t*)(dob + DO_GV); bf16_t* KT = (bf16_t*)(dob + DO_KT);
    bf16_t* Qb = (bf16_t*)(dob + DO_Q); bf16_t* KVP = (bf16_t*)(dob + DO_KVP); bf16_t* KVS = (bf16_t*)(ws + WS_KVS);
    const int lo = a.ph_lo, hi = a.ph_hi;
    volatile LAS unsigned* MISC = (volatile LAS unsigned*)(lds + LDS_MISC);
    if (tid < 16) MISC[tid] = 0u;
    __syncthreads();
    unsigned* ctl = (unsigned*)(ws + WS_CTL);
    XcdBarrier xbar = xcd_barrier_post(ctl, MISC + 8);
    if (a.ph_lo < 0) grid.sync();
#ifndef PH_MASK
#define PH_MASK 0xFFFF
#endif
#define IN(k) (((PH_MASK >> (k)) & 1) && lo <= (k) && (k) < hi)
#define SEAM(k) do { if (IN((k) + 1)) xcd_barrier(xbar); } while (0)

#define KV_GEMM(half, Gx, cx) do { pg8::Gemm g_{bufA + 384 + (size_t)(half) * 32768 * 768, Wukv_t, 32768, 1024, 256, 768}; pg8::StaticOrder S_; S_.init(32768, 1024, (Gx), (cx)); \
        pg8::EpiBf16<0> E_{(half) ? KVS : KVP, 1024, rskv + (half) * 32768, 1.f}; pg8::gemm_phase<pg8::EpiBf16<0>, pg8::StaticOrder, true>(lds, g_, S_, E_); } while (0)
    if (IN(0)) {
        LAS float* scs = (LAS float*)lds;
        LAS float* red = (LAS float*)(lds + 24576);
        for (int i = tid; i < 6 * 1024; i += 512) { const int b = i >> 10, k = i & 1023; const float c = b < 2 ? a.in[2][b * 1024 + k] : a.in[3][(b - 2) * 1024 + k]; scs[i] = siluf(c); }
        __syncthreads();
        for (int it = bid; it < 256; it += G) {
            const bool fin = it >= 192; const float* W = fin ? a.in[22] : a.in[4]; const float* bias = fin ? a.in[23] : a.in[5];
            const int N = fin ? 2048 : 6144, n0 = (fin ? it - 192 : it) * 32, col = tid & 31, ksl = tid >> 5;
            float acc[6] = {0.f, 0.f, 0.f, 0.f, 0.f, 0.f};
#pragma unroll 8
            for (int kk = 0; kk < 64; ++kk) { const int k = ksl * 64 + kk; const float w = W[(size_t)k * N + n0 + col];
#pragma unroll
                for (int b = 0; b < 6; ++b) acc[b] += scs[b * 1024 + k] * w; }
#pragma unroll
            for (int b = 0; b < 6; ++b) red[(ksl * 6 + b) * 32 + col] = acc[b];
            __syncthreads();
            if (tid < 192) { const int b = tid >> 5; float s = bias[n0 + col];
#pragma unroll
                for (int q = 0; q < 16; ++q) s += red[(q * 6 + b) * 32 + col];
                (fin ? modf_ : mod)[(size_t)b * N + n0 + col] = s; }
            __syncthreads();
        }
        SEAM(0);
    }
    if (IN(1)) {
        LAS float* scr = (LAS float*)(lds + wave * 8448);
        constexpr int I_IN = 16 * 88, I_UQ = 6 * 24, I_UKV = 4 * 32, I_OUT = 16 * 32, I_1 = 16 * 128, I_2 = 64 * 32;
        for (int it = gw; it < I_IN + I_UQ + I_UKV + I_OUT + I_1 + I_2; it += NGW) {
            int r = it;
            if (r < I_IN) { transpose_item(a.in[7], 1024, 2768, N_IN, Win_t, nullptr, 1, scr, r, lane); continue; } r -= I_IN;
            if (r < I_UQ) { transpose_item(a.in[9], 384, 768, 768, Wuq_t, a.in[8], 2, scr, r, lane); continue; } r -= I_UQ;
            if (r < I_UKV) { transpose_item(a.in[11], 256, 1024, 1024, Wukv_t, a.in[10], 0, scr, r, lane); continue; } r -= I_UKV;
            if (r < I_OUT) { transpose_item(a.in[18], 1024, 1024, 1024, Wout_t, nullptr, 0, scr, r, lane); continue; } r -= I_OUT;
            if (r < I_1) { transpose_item(a.in[20], 1024, 4096, 4096, W1_t, nullptr, 0, scr, r, lane); continue; } r -= I_1;
            transpose_item(a.in[21], 4096, 1024, 1024, W2_t, nullptr, 0, scr, r, lane);
        }
        for (int m = gw; m < M_TOK; m += 2 * NGW) { const int m1 = (m + NGW < M_TOK) ? m + NGW : m;
            const float* xr0 = m < 32768 ? xp + (size_t)m * DM : xs + (size_t)(m - 32768) * DM; const float* xr1 = m1 < 32768 ? xp + (size_t)m1 * DM : xs + (size_t)(m1 - 32768) * DM;
            const float* md0 = mod + (size_t)seq_of_row(m) * 6144; const float* md1 = mod + (size_t)seq_of_row(m1) * 6144;
            norm_mod_row2<true>(xr0, xr1, a.in[6], md0 + 1024, md0, md1 + 1024, md1, R1 + (size_t)m * DM, R1 + (size_t)m1 * DM, lane); }
        SEAM(1);
    }
    if (IN(2)) {
#if ENABLE_MLA || ENABLE_GDN
        pg8::Gemm g{R1, Win_t, M_TOK, N_IN, 1024, 1024}; pg8::StaticOrder S; S.init(M_TOK, N_IN, G, bid);
        pg8::EpiProj E{bufA, bufQKV, bufZ};
        pg8::gemm_phase<pg8::EpiProj, pg8::StaticOrder, true>(lds, g, S, E);
#endif
        SEAM(2);
    }
    if (IN(3)) {
#if ENABLE_MLA || ENABLE_GDN
        for (int m = gw; m < M_TOK; m += NGW) {
            const unsigned* rowp = (const unsigned*)(bufA + (size_t)m * 768);
            float s = 0.f;
#pragma unroll
            for (int j = 0; j < 3; ++j) { const unsigned w = rowp[lane + 64 * j]; const float x0 = bf_lo(w), x1 = bf_hi(w); s += x0 * x0 + x1 * x1; }
            s = wave_sum(s);
            float s2 = 0.f;
#pragma unroll
            for (int j = 0; j < 2; ++j) { const unsigned w = rowp[192 + lane + 64 * j]; const float x0 = bf_lo(w), x1 = bf_hi(w); s2 += x0 * x0 + x1 * x1; }
            s2 = wave_sum(s2);
            if (lane == 0) { rsq[m] = rsqrtf(s * (1.f / 384.f) + EPS); rskv[m] = rsqrtf(s2 * (1.f / 256.f) + EPS); }
            const int pos = m - seq_start(seq_of_row(m));
            const bf16_t* kr = bufA + (size_t)m * 768 + 640;
            unsigned ow = 0;
            if (lane < 32) { const float x1 = bf1(kr[lane]), x2 = bf1(kr[lane + 32]); const double rev = (double)pos * c_invrev[lane]; const float fr_ = (float)(rev - rint(rev));
                const float sn = __builtin_amdgcn_sinf(fr_), cs = __builtin_amdgcn_cosf(fr_); ow = cvt_pk(x1 * cs - x2 * sn, x2 * cs + x1 * sn); }
            float gv = 0.f;
            if (lane < 8) { float g_, b_; gate_vals(bufA, m, lane >> 2, lane & 3, a.in[13], a.in[14], a.in[15], a.in[16], g_, b_); gv = g_; gates[(size_t)m * 16 + 8 + lane] = b_; }
            (void)gv;
            asm volatile("s_waitcnt vmcnt(0)" ::: "memory");
            if (lane < 32) ((unsigned*)(bufA + (size_t)m * 768 + 640))[lane] = ow;
        }
#endif
#if ENABLE_GDN
        __syncthreads();
        for (int it = bid; it < 4096; it += G) gdn_prep_item(it >> 2, it & 3, lds, bufQKV, a.in[12], bufA, a.in[13], a.in[14], a.in[15], a.in[16], GQ, GK, GV, KT, TINV, ATT, gates);
#endif
        SEAM(3);
    }
    if (IN(4)) {
#if ENABLE_GDN
#if GDN_DBG == 2
        for (int m = gw; m < M_TOK; m += NGW) { const int hh = lane >> 4, cgx = m >> 6, ii = m & 63;
            for (int e = 0; e < 8; ++e) { const size_t o = (size_t)m * 512 + lane * 8 + e; const int dd = e & 1;
                OD[o] = f2bf(bf1(GQ[o]) + bf1(GK[o]) + bf1(GV[o]) + gates[(size_t)m * 16 + (lane & 15)]);
                const size_t tb = ((size_t)((cgx * 4 + hh) * 2 + dd) * 64 + ii) * 64 + (lane & 15) * 4 + (e >> 1);
                OD[(size_t)M_TOK * 512 + o] = f2bf(bf1(TINV[tb]) + bf1(ATT[tb]) + bf1(KT[((size_t)(cgx * 4 + hh) * 128 + (lane & 15) * 8 + e) * 64 + ii])); } }
#else
        if (G == 256) {
            const int xcd = bid & 7, li = bid >> 3;
            if (li < 16) gdn_scan_chain<16>((li >> 3) * 8 + xcd, li & 7, lds, gates, GQ, GK, GV, TINV, ATT, OD);
            else { gdn_scan_chain<32>(16 + ((li - 16) >> 2) * 8 + xcd, (li - 16) & 3, lds, gates, GQ, GK, GV, TINV, ATT, OD);
#if ENABLE_MLA
                const int cx = (li - 16) * 8 + xcd; KV_GEMM(0, 128, cx); KV_GEMM(1, 128, cx);
#endif
            }
        } else
        for (int ch = bid; ch < 192; ch += G) gdn_scan_chain<32>(ch >> 2, ch & 3, lds, gates, GQ, GK, GV, TINV, ATT, OD);
#endif
#endif
        SEAM(4);
    }
    if (IN(5)) {
        for (int m0 = gw; m0 < M_TOK; m0 += 2 * NGW) {
            u32x4 ofv[2], obv[2], zvv[2]; int mr[2];
#pragma unroll
            for (int k = 0; k < 2; ++k) { mr[k] = (m0 + k * NGW < M_TOK) ? m0 + k * NGW : m0;
#if ENABLE_GDN
                { const size_t oo = ((size_t)((lane >> 4) * 4 + ((lane & 15) >> 2)) * M_TOK + mr[k]) * 32 + (lane & 3) * 8;
                  ofv[k] = *(const u32x4*)(OD + oo); obv[k] = *(const u32x4*)(OD + (size_t)16 * M_TOK * 32 + oo); }
                zvv[k] = *(const u32x4*)(bufZ + (size_t)mr[k] * 512 + lane * 8);
#endif
            }
            const f32x4 g0 = *(const f32x4*)(a.in[17] + (lane & 15) * 8), g1 = *(const f32x4*)(a.in[17] + (lane & 15) * 8 + 4);
            const float gg[8] = {g0[0], g0[1], g0[2], g0[3], g1[0], g1[1], g1[2], g1[3]};
#pragma unroll
            for (int k = 0; k < 2; ++k) {
                u32x4 ov = {0u, 0u, 0u, 0u};
#if ENABLE_GDN
                const u32x4 of = ofv[k], ob = obv[k], zv = zvv[k];
                float o[8] = {bf_lo(of.x) + bf_lo(ob.x), bf_hi(of.x) + bf_hi(ob.x), bf_lo(of.y) + bf_lo(ob.y), bf_hi(of.y) + bf_hi(ob.y),
                              bf_lo(of.z) + bf_lo(ob.z), bf_hi(of.z) + bf_hi(ob.z), bf_lo(of.w) + bf_lo(ob.w), bf_hi(of.w) + bf_hi(ob.w)};
                const float z[8] = {bf_lo(zv.x), bf_hi(zv.x), bf_lo(zv.y), bf_hi(zv.y), bf_lo(zv.z), bf_hi(zv.z), bf_lo(zv.w), bf_hi(zv.w)};
                float ss = 0.f;
#pragma unroll
                for (int e = 0; e < 8; ++e) ss += o[e] * o[e];
                ss = row16_sum(ss);
                const float rstd = rsqrtf(ss * (1.f / 128.f) + EPS);
#pragma unroll
                for (int e = 0; e < 8; ++e) o[e] = o[e] * rstd * gg[e] * siluf(z[e]);
                ov.x = cvt_pk(o[0], o[1]); ov.y = cvt_pk(o[2], o[3]); ov.z = cvt_pk(o[4], o[5]); ov.w = cvt_pk(o[6], o[7]);
#endif
                *(u32x4*)(R1 + (size_t)mr[k] * DM + 512 + lane * 8) = ov;
#if !ENABLE_MLA
                *(u32x4*)(R1 + (size_t)mr[k] * DM + lane * 8) = (u32x4){0u, 0u, 0u, 0u};
#endif
            }
        }
#if ENABLE_MLA
        __syncthreads();
        { pg8::Gemm g{bufA, Wuq_t, M_TOK, 768, 384, 768}; pg8::StaticOrder S; S.init(M_TOK, 768, G, bid);
          pg8::EpiBf16<0> E{Qb, 768, rsq, QSCALE};
          pg8::gemm_phase<pg8::EpiBf16<0>, pg8::StaticOrder, true>(lds, g, S, E); }
        if (G != 256) { KV_GEMM(0, G, bid); KV_GEMM(1, G, bid); }
#endif
        SEAM(5);
    }
    if (IN(6)) {
#if ENABLE_MLA
        const int vcu = (G % 8 == 0) ? (bid % 8) * (G / 8) + bid / 8 : bid;
        for (int rep_ = 0; rep_ < ATT_REP; ++rep_)
        for (int u = vcu; u < 1024; u += G) {
            int sq, h, qb;
            if (u < 512) { sq = u >> 8; h = (u >> 6) & 3; qb = u & 63; } else { const int v = u - 512; sq = 2 + (v >> 7); h = (v >> 5) & 3; qb = v & 31; }
            const int s0 = seq_start(sq), sl = seq_len(sq); const size_t q0 = (size_t)s0 + qb * 256;
            const bf16_t* kvb = (sq < 2 ? KVP + (size_t)s0 * 1024 : KVS + (size_t)(s0 - 32768) * 1024) + h * 256;
            att::attn_unit(Qb + q0 * 768 + h * 192, kvb, kvb + 128, bufA + (size_t)s0 * 768 + 640,
                           R1 + q0 * DM + h * 128, sl, qb * 256, (char*)lds_raw);
        }
#endif
        SEAM(6);
    }
    if (IN(7)) {
        pg8::Gemm g{R1, Wout_t, M_TOK, DM, 1024, 1024}; pg8::StaticOrder S; S.init(M_TOK, DM, G, bid);
        pg8::EpiResB<0> E{xp, xs, X1, mod + 2048, 0};
        pg8::gemm_phase<pg8::EpiResB<0>, pg8::StaticOrder, true>(lds, g, S, E);
        SEAM(7);
    }
    if (IN(8)) {
        for (int m = gw; m < M_TOK; m += 4 * NGW) norm_rows_b<true, 4>(m, NGW, X1, a.in[19], mod, 6144, 4096, 3072, R1, nullptr, lane);
        SEAM(8);
    }
#pragma unroll 1
    for (int half = 0; half < 2; ++half) {
        if (IN(9 + 2 * half)) {
            pg8::Gemm g{R1 + (size_t)half * 32768 * DM, W1_t, 32768, FF, 1024, 1024}; pg8::StaticOrder S; S.init(32768, FF, G, bid);
            pg8::EpiBf16<1> E{HID, FF, nullptr, 1.f};
            pg8::gemm_phase<pg8::EpiBf16<1>, pg8::StaticOrder, true>(lds, g, S, E);
            SEAM(9 + 2 * half);
        }
        if (IN(10 + 2 * half)) {
            pg8::Gemm g{HID, W2_t, 32768, DM, FF, FF}; pg8::StaticOrder S; S.init(32768, DM, G, bid);
            pg8::EpiResB<1> E{xp, xs, X1, mod + 5120, half * 32768};
            pg8::gemm_phase<pg8::EpiResB<1>, pg8::StaticOrder, true>(lds, g, S, E);
            SEAM(10 + 2 * half);
        }
    }
    if (IN(13)) {
        for (int m = gw; m < M_TOK; m += 4 * NGW) norm_rows_b<false, 4>(m, NGW, X1, a.in[24], modf_, 2048, 1024, 0, nullptr, a.out, lane);
    }
#undef IN
#undef SEAM
}

extern "C" void kernel_launch(void* const* d_in, const int* in_sizes, int n_in, void* d_out, int out_size, void* d_ws, size_t ws_size, hipStream_t stream) {
    static int grid = 0;
    if (grid == 0) {
        if (n_in != 25 || out_size != M_TOK * DM || ws_size < WS_END) { fprintf(stderr, "kernel_launch: unexpected shapes (n_in %d out %d ws %zu)\n", n_in, out_size, ws_size); grid = -1; return; }
        int dev = 0, cus = 0, per_cu = 0;
        hipGetDevice(&dev); hipDeviceGetAttribute(&cus, hipDeviceAttributeMultiprocessorCount, dev);
        if (hipFuncSetAttribute((const void*)fwd_kernel, hipFuncAttributeMaxDynamicSharedMemorySize, LDS_BYTES) != hipSuccess) { fprintf(stderr, "kernel_launch: hipFuncSetAttribute failed\n"); grid = -1; return; }
        if (hipOccupancyMaxActiveBlocksPerMultiprocessor(&per_cu, (const void*)fwd_kernel, 512, LDS_BYTES) != hipSuccess || per_cu < 1) { fprintf(stderr, "kernel_launch: occupancy query says %d\n", per_cu); per_cu = 1; }
        (void)hipGetLastError();
        grid = cus * 1;
    }
    if (grid < 0) return;
    if (hipMemsetAsync((char*)d_ws + WS_CTL, 0, CTL_BYTES, stream) != hipSuccess) { fprintf(stderr, "kernel_launch: memset failed\n"); return; }
    Args a{};
    for (int i = 0; i < 25; ++i) a.in[i] = (const float*)d_in[i];
    a.out = (float*)d_out; a.ws = (unsigned char*)d_ws;
#if N_LAUNCH_MODE == 1
    const int cuts[2] = {0, NPHASE}; const int nl = 1;
#else
    int cuts[NPHASE + 1]; for (int i = 0; i <= NPHASE; ++i) cuts[i] = i; const int nl = NPHASE;
#endif
    for (int li = 0; li < nl; ++li) {
        a.ph_lo = cuts[li]; a.ph_hi = cuts[li + 1];
        void* args[] = {&a};
        const hipError_t e = hipLaunchCooperativeKernel((const void*)fwd_kernel, dim3(grid), dim3(512), args, LDS_BYTES, stream);
        if (e != hipSuccess) { fprintf(stderr, "kernel_launch: cooperative launch %d failed: %s (grid %d)\n", li, hipGetErrorString(e), grid); break; }
    }
}
```
